# Optimizing an MI355X kernel written in HIP

```python
import math
import jax, jax.numpy as jnp
from jax import lax
import numpy as np

D_MODEL = 1024
BATCH = 32
SEQ = 2048
DEPTH = 1

HEAD_DIM = 64
DIFF_V_DIM = 2 * HEAD_DIM
DIFF_HEADS = D_MODEL // (2 * DIFF_V_DIM)
SB_HEAD_DIM = HEAD_DIM
SB_HEADS = D_MODEL // (2 * SB_HEAD_DIM)
MIX_WIDTH = DIFF_HEADS * DIFF_V_DIM + SB_HEADS * SB_HEAD_DIM
DIFF_QK = DIFF_HEADS * 2 * HEAD_DIM
DIFF_V = DIFF_HEADS * DIFF_V_DIM
SB_QKV = SB_HEADS * SB_HEAD_DIM
IN_COLS = 2 * DIFF_QK + DIFF_V + 3 * SB_QKV
ROPE_DIM = HEAD_DIM // 4
ROPE_THETA = 500000.0
D_FF = ((8 * D_MODEL // 3 + 255) // 256) * 256
Q_BLOCK = 128
NORM_EPS = 1e-5

kernel_name = "hybrid_diffattn_stickbreaking_swiglu"


def rmsnorm(x, g, eps=NORM_EPS):
    xf = x.astype(jnp.float32)
    y = xf * lax.rsqrt(jnp.mean(xf * xf, axis=-1, keepdims=True) + eps)
    return (y * g.astype(jnp.float32)).astype(x.dtype)


def partial_rope(t, positions):
    half = ROPE_DIM // 2
    inv_freq = ROPE_THETA ** (-jnp.arange(half, dtype=jnp.float32) / half)
    ang = positions.astype(jnp.float32)[..., None] * inv_freq
    cos = jnp.cos(ang)[:, :, None, :]
    sin = jnp.sin(ang)[:, :, None, :]
    tf = t.astype(jnp.float32)
    x1, x2, rest = tf[..., :half], tf[..., half:ROPE_DIM], tf[..., ROPE_DIM:]
    return jnp.concatenate([x1 * cos - x2 * sin, x2 * cos + x1 * sin, rest], axis=-1)


def to_blocks(t):
    b, s = t.shape[:2]
    return t.reshape(b, s // Q_BLOCK, Q_BLOCK, *t.shape[2:]).swapaxes(0, 1)


def from_blocks(t):
    nb, b, qb = t.shape[:3]
    return t.swapaxes(0, 1).reshape(b, nb * qb, *t.shape[3:])


def differential_attention(q, k, v, lam):
    b, s = q.shape[:2]
    scale = HEAD_DIM ** -0.5
    key_idx = jnp.arange(s)

    def block(args):
        qb, i = args
        sc = jnp.einsum('bqhd,bkhd->bhqk', qb, k) * scale
        q_idx = i * Q_BLOCK + jnp.arange(Q_BLOCK)
        causal = key_idx[None, :] <= q_idx[:, None]
        sc = jnp.where(causal, sc, -jnp.inf)
        p = jax.nn.softmax(sc, axis=-1).reshape(b, DIFF_HEADS, 2, Q_BLOCK, s)
        a = p[:, :, 0] - lam * p[:, :, 1]
        return jnp.einsum('bhqk,bkhd->bqhd', a, v)

    out = lax.map(block, (to_blocks(q), jnp.arange(s // Q_BLOCK)))
    return from_blocks(out)


def stick_breaking_attention(q, k, v):
    b, s = q.shape[:2]
    scale = SB_HEAD_DIM ** -0.5
    key_idx = jnp.arange(s)

    def block(args):
        qb, i = args
        z = jnp.einsum('bqhd,bkhd->bhqk', qb, k) * scale
        q_idx = i * Q_BLOCK + jnp.arange(Q_BLOCK)
        strict = key_idx[None, :] < q_idx[:, None]
        log_beta = jax.nn.log_sigmoid(z)
        log_1mb = jnp.where(strict, jax.nn.log_sigmoid(-z), 0.0)
        later = lax.cumsum(log_1mb, axis=3, reverse=True) - log_1mb
        a = jnp.where(strict, jnp.exp(log_beta + later), 0.0)
        return jnp.einsum('bhqk,bkhd->bqhd', a, v)

    out = lax.map(block, (to_blocks(q), jnp.arange(s // Q_BLOCK)))
    return from_blocks(out)


def setup_inputs(seed: int = 0) -> dict:
    key = jax.random.key(seed)
    ks = jax.random.split(key, 18)
    f32 = jnp.float32

    def nrm(k, shape, scale):
        return jax.random.normal(k, shape, f32) * scale

    def gain(k, shape):
        return 1.0 + 0.02 * jax.random.normal(k, shape, f32)

    x = jax.random.normal(ks[0], (BATCH, SEQ, D_MODEL), f32)
    offset = jax.random.randint(ks[1], (BATCH, 1), 0, 1024, dtype=jnp.int32)
    positions = offset + jnp.arange(SEQ, dtype=jnp.int32)[None, :]
    return {
        "x": x,
        "positions": positions,
        "norm_attn_g": gain(ks[2], (DEPTH, D_MODEL)),
        "w_in": nrm(ks[3], (DEPTH, D_MODEL, IN_COLS), D_MODEL ** -0.5),
        "lambda_q1": nrm(ks[4], (DEPTH, HEAD_DIM), 0.1),
        "lambda_k1": nrm(ks[5], (DEPTH, HEAD_DIM), 0.1),
        "lambda_q2": nrm(ks[6], (DEPTH, HEAD_DIM), 0.1),
        "lambda_k2": nrm(ks[7], (DEPTH, HEAD_DIM), 0.1),
        "diff_subln_g": gain(ks[8], (DEPTH, DIFF_V_DIM)),
        "sb_norm_g": gain(ks[9], (DEPTH, SB_HEAD_DIM)),
        "w_out": nrm(ks[10], (DEPTH, MIX_WIDTH, D_MODEL), MIX_WIDTH ** -0.5),
        "norm_ffn_g": gain(ks[11], (DEPTH, D_MODEL)),
        "w_gate": nrm(ks[12], (DEPTH, D_MODEL, D_FF), D_MODEL ** -0.5),
        "w_up": nrm(ks[13], (DEPTH, D_MODEL, D_FF), D_MODEL ** -0.5),
        "w_down": nrm(ks[14], (DEPTH, D_FF, D_MODEL), D_FF ** -0.5),
        "final_norm_g": gain(ks[15], (D_MODEL,)),
    }


def reference(x, positions, norm_attn_g, w_in, lambda_q1, lambda_k1, lambda_q2, lambda_k2,
              diff_subln_g, sb_norm_g, w_out, norm_ffn_g, w_gate, w_up, w_down, final_norm_g):
    b, s, _ = x.shape
    f32 = jnp.float32
    for layer in range(DEPTH):
        lambda_init = 0.8 - 0.6 * math.exp(-0.3 * layer)
        h = rmsnorm(x, norm_attn_g[layer])
        proj = h @ w_in[layer]
        o1 = DIFF_QK
        o2 = o1 + DIFF_QK
        o3 = o2 + DIFF_V
        o4 = o3 + SB_QKV
        o5 = o4 + SB_QKV
        dq = proj[..., :o1].reshape(b, s, 2 * DIFF_HEADS, HEAD_DIM)
        dk = proj[..., o1:o2].reshape(b, s, 2 * DIFF_HEADS, HEAD_DIM)
        dv = proj[..., o2:o3].reshape(b, s, DIFF_HEADS, DIFF_V_DIM).astype(f32)
        dq = partial_rope(dq, positions)
        dk = partial_rope(dk, positions)
        lam = (jnp.exp(jnp.sum(lambda_q1[layer].astype(f32) * lambda_k1[layer].astype(f32)))
               - jnp.exp(jnp.sum(lambda_q2[layer].astype(f32) * lambda_k2[layer].astype(f32)))
               + lambda_init)
        d_out = differential_attention(dq, dk, dv, lam)
        d_out = rmsnorm(d_out, diff_subln_g[layer]) * (1.0 - lambda_init)
        d_out = d_out.reshape(b, s, DIFF_V).astype(x.dtype)
        sq = proj[..., o3:o4].reshape(b, s, SB_HEADS, SB_HEAD_DIM).astype(f32)
        sk = proj[..., o4:o5].reshape(b, s, SB_HEADS, SB_HEAD_DIM).astype(f32)
        sv = proj[..., o5:].reshape(b, s, SB_HEADS, SB_HEAD_DIM).astype(f32)
        s_out = stick_breaking_attention(sq, sk, sv)
        s_out = rmsnorm(s_out, sb_norm_g[layer]).reshape(b, s, SB_QKV).astype(x.dtype)
        mix = jnp.concatenate([d_out, s_out], axis=-1)
        x = x + mix @ w_out[layer]
        h2 = rmsnorm(x, norm_ffn_g[layer])
        x = x + (jax.nn.silu(h2 @ w_gate[layer]) * (h2 @ w_up[layer])) @ w_down[layer]
    return rmsnorm(x, final_norm_g)
```

```cpp
#include <hip/hip_runtime.h>
#include <hip/hip_cooperative_groups.h>
#include <hip/hip_bf16.h>
#include <cstdio>
#include <cstdint>
#include <cmath>
__device__ __forceinline__ int opaque_tid() { int t = threadIdx.x; asm volatile("" : "+v"(t)); return t; }
namespace pg8 {
#define PG8_LAS __attribute__((address_space(3)))
typedef unsigned short bf16_t;
typedef short bf16x8 __attribute__((ext_vector_type(8)));
typedef float f32x4 __attribute__((ext_vector_type(4)));
typedef unsigned u32x4 __attribute__((ext_vector_type(4)));
constexpr int BM = 256, BK = 64, HALF = 128, HTB = HALF * BK * 2  , STAGE_BYTES = 8 * HTB, NXCD = 8, WGM = 8;

__host__ __device__ __forceinline__ int lds_byte(int r, int c) { const int st = (r >> 4) * 2 + (c >> 5), rr = r & 15, cc = c & 31, ob = rr * 64 + cc * 2; return st * 1024 + (ob ^ (((ob >> 9) & 1) << 5)); }
__host__ __device__ __forceinline__ void stage_rc(int b, int& R, int& C) { const int st = b / 1024, sb = b % 1024, swz = sb ^ (((sb >> 9) & 1) << 5); R = (st >> 1) * 16 + swz / 64; C = (st & 1) * 32 + (swz % 64) / 2; }
__host__ __device__ __forceinline__ int perm32(int rho) { const int n = rho >> 4, i = rho & 15; return 8 * (i >> 2) + 4 * n + (i & 3); }

struct Unit { int pm, pn; };
struct Gemm { const bf16_t* A; const bf16_t* Bt; int M, N, K; };

struct StaticOrder {
    int nM, nN, nwg, G, c;
    __host__ __device__ void init(int M, int N, int G_, int c_) { nM = M / BM; nN = N / BM; nwg = nM * nN; G = G_; c = c_; }
    __host__ __device__ bool next(int i, Unit& u) const {
        const long L = (long)i * G + c; if (L >= nwg) return false;
        int wgid = (int)L; { const int q = nwg / NXCD, r = nwg % NXCD, xcd = wgid % NXCD, off = wgid / NXCD; wgid = (xcd < r ? xcd * (q + 1) : r * (q + 1) + (xcd - r) * q) + off; }
        const int nig = WGM * nN, gid = wgid / nig, fm = gid * WGM, gsz = (nM - fm) < WGM ? (nM - fm) : WGM;
        u.pm = fm + ((wgid % nig) % gsz); u.pn = (wgid % nig) / gsz; return true;
    }
    __device__ __forceinline__ void a_ready(const Unit&) const {}
    __device__ __forceinline__ void done(const Unit&) const {}
};

__device__ __forceinline__ unsigned cvt_pk_bf16(float lo, float hi) { unsigned r; asm volatile("v_cvt_pk_bf16_f32 %0, %1, %2" : "=v"(r) : "v"(lo), "v"(hi)); return r; }
typedef unsigned u32x2 __attribute__((ext_vector_type(2)));
__device__ __forceinline__ float xsum_fq(float s) {
    auto a = __builtin_amdgcn_permlane16_swap(__float_as_uint(s), __float_as_uint(s), false, false); s = __uint_as_float(a[0]) + __uint_as_float(a[1]);
    auto b = __builtin_amdgcn_permlane32_swap(__float_as_uint(s), __float_as_uint(s), false, false); return __uint_as_float(b[0]) + __uint_as_float(b[1]); }
__device__ __forceinline__ float xchg16(float v, int fq) {
    auto a = __builtin_amdgcn_permlane16_swap(__float_as_uint(v), __float_as_uint(v), false, false); return __uint_as_float((fq & 1) ? a[0] : a[1]); }
typedef float f32x2 __attribute__((ext_vector_type(2)));
constexpr float QSCALE = 0.125f * 1.4426950408889634f;

struct EpiInProj {
    static constexpr bool PERM = true, AFTER_DRAIN = false;
    bf16_t* O; const float* rs; const float* rope;
    bf16_t* KT; bf16_t* VT;
    __device__ __forceinline__ bf16_t* dst16(int region, int row, int col) const {
        if (region == 1) { const int cr = col - 512, b = row >> 11, rb = row & 2047; return KT + ((size_t)(b * 8 + (cr >> 6)) << 17) + (rb >> 6) * 4096 + ((cr & 63) >> 3) * 512 + (rb & 63) * 8; }
        if (region == 2) { const int cr = col - 1024, b = row >> 11, rb = row & 2047, r64 = rb & 63, ch = (cr & 63) >> 3;
            return VT + ((size_t)(b * 8 + (cr >> 6)) << 17) + (rb >> 6) * 4096 + ((ch >> 2) * 4 + (r64 >> 4)) * 512 + (r64 & 15) * 32 + (ch & 3) * 8; }
        return O + (size_t)row * 3072 + col; }
    __device__ __forceinline__ void operator()(const f32x4 (&acc)[2][2][4][2], const Unit& u, int wr, int wc, int fr, int fq) const {
        const int row0 = u.pm * BM + wr * 64 + fr, region = u.pn >> 1;
        const bool do_rope = (region < 2) && ((wc & 1) == 0);
        const float sc = (region == 0 || region == 3) ? QSCALE : 1.0f;
        const int col0 = u.pn * BM + wc * 32 + 8 * fq;
        const float sgn = (fq == 0) ? -1.0f : 1.0f;
        float rv[8];
#pragma unroll
        for (int gI = 0; gI < 8; ++gI) rv[gI] = rs[row0 + (gI >> 2) * HALF + (gI & 3) * 16];
        if (do_rope) {
            const int fo = 4 * (fq & 1);
            f32x4 nx[2];
            { const float* rp = rope + (size_t)row0 * 16 + fo; nx[0] = *(const f32x4*)(rp); nx[1] = *(const f32x4*)(rp + 8); }
#pragma unroll
            for (int gI = 0; gI < 8; ++gI) {
                const int ai = gI >> 2, m = gI & 3, row = row0 + ai * HALF + m * 16;
                const f32x4 cs = nx[0], sn = nx[1];
                if (gI < 7) { const float* rp = rope + (size_t)(row0 + ((gI + 1) >> 2) * HALF + ((gI + 1) & 3) * 16) * 16 + fo; nx[0] = *(const f32x4*)(rp); nx[1] = *(const f32x4*)(rp + 8); }
                asm volatile("" ::: "memory");
                const float r = rv[gI] * sc;
#pragma unroll
                for (int bj = 0; bj < 2; ++bj) {
                    f32x4 v0 = acc[ai][bj][m][0] * r, v1 = acc[ai][bj][m][1] * r;
                    if (fq < 2) {
                        const f32x4 a = v0, b = v1;
                        v0[0] = a[0] * cs[0] - a[1] * sn[0]; v0[1] = a[1] * cs[0] + a[0] * sn[0]; v0[2] = a[2] * cs[1] - a[3] * sn[1]; v0[3] = a[3] * cs[1] + a[2] * sn[1];
                        v1[0] = b[0] * cs[2] - b[1] * sn[2]; v1[1] = b[1] * cs[2] + b[0] * sn[2]; v1[2] = b[2] * cs[3] - b[3] * sn[3]; v1[3] = b[3] * cs[3] + b[2] * sn[3];
                    }
                    u32x4 w; w.x = cvt_pk_bf16(v0[0], v0[1]); w.y = cvt_pk_bf16(v0[2], v0[3]); w.z = cvt_pk_bf16(v1[0], v1[1]); w.w = cvt_pk_bf16(v1[2], v1[3]);
                    __builtin_nontemporal_store(w, (u32x4*)dst16(region, row, col0 + bj * HALF));
                }
            }
        } else {
#pragma unroll
            for (int gI = 0; gI < 8; ++gI) {
                const int ai = gI >> 2, m = gI & 3, row = row0 + ai * HALF + m * 16;
                const float r = rv[gI] * sc;
#pragma unroll
                for (int bj = 0; bj < 2; ++bj) {
                    const f32x4 v0 = acc[ai][bj][m][0] * r, v1 = acc[ai][bj][m][1] * r;
                    u32x4 w; w.x = cvt_pk_bf16(v0[0], v0[1]); w.y = cvt_pk_bf16(v0[2], v0[3]); w.z = cvt_pk_bf16(v1[0], v1[1]); w.w = cvt_pk_bf16(v1[2], v1[3]);
                    __builtin_nontemporal_store(w, (u32x4*)dst16(region, row, col0 + bj * HALF));
                }
            }
        }
    }
};

template <bool BASE_BF16> struct EpiResid {
    static constexpr bool PERM = false, AFTER_DRAIN = false;
    const void* base; bf16_t* xb; float* ssqp;
    __device__ __forceinline__ void ld4(f32x4 (&d)[2][2], size_t off) const {
#pragma unroll
        for (int bj = 0; bj < 2; ++bj)
#pragma unroll
            for (int n = 0; n < 2; ++n) {
                if (BASE_BF16) { const u32x2 w = *(const u32x2*)((const bf16_t*)base + off + bj * HALF + n * 16);
                    d[bj][n][0] = __builtin_bit_cast(float, w.x << 16); d[bj][n][1] = __builtin_bit_cast(float, w.x & 0xffff0000u); d[bj][n][2] = __builtin_bit_cast(float, w.y << 16); d[bj][n][3] = __builtin_bit_cast(float, w.y & 0xffff0000u); }
                else d[bj][n] = *(const f32x4*)((const float*)base + off + bj * HALF + n * 16); }
    }
    __device__ __forceinline__ void operator()(const f32x4 (&acc)[2][2][4][2], const Unit& u, int wr, int wc, int fr, int fq) const {
        const int col0 = u.pn * BM + wc * 32 + 4 * fq, rowb = u.pm * BM + wr * 64 + fr;
        f32x4 nb[2][2];
        ld4(nb, (size_t)rowb * 1024 + col0);
#pragma unroll
        for (int gI = 0; gI < 8; ++gI) {
            const int ai = gI >> 2, m = gI & 3, row = rowb + ai * HALF + m * 16; const size_t off = (size_t)row * 1024 + col0; float s = 0.f;
            f32x4 cb[2][2];
#pragma unroll
            for (int bj = 0; bj < 2; ++bj)
#pragma unroll
                for (int n = 0; n < 2; ++n) cb[bj][n] = nb[bj][n];
            if (gI < 7) ld4(nb, (size_t)(rowb + ((gI + 1) >> 2) * HALF + ((gI + 1) & 3) * 16) * 1024 + col0);
            asm volatile("" ::: "memory");
#pragma unroll
            for (int bj = 0; bj < 2; ++bj)
#pragma unroll
                for (int n = 0; n < 2; ++n) {
                    const f32x4 o = cb[bj][n] + acc[ai][bj][m][n];
                    s += (o[0] * o[0] + o[1] * o[1]) + (o[2] * o[2] + o[3] * o[3]);
                    u32x2 w; w.x = cvt_pk_bf16(o[0], o[1]); w.y = cvt_pk_bf16(o[2], o[3]); *(u32x2*)(xb + off + bj * HALF + n * 16) = w;
                }
            s = xsum_fq(s);
            if (fq == 0) ssqp[(size_t)row * 16 + u.pn * 4 + wc] = s;
        }
    }
};
__device__ __forceinline__ float sum16(const float* p) { const f32x4 a = *(const f32x4*)p, b = *(const f32x4*)(p + 4), c = *(const f32x4*)(p + 8), d = *(const f32x4*)(p + 12);
    const f32x4 t = (a + b) + (c + d); return (t[0] + t[1]) + (t[2] + t[3]); }

struct EpiFinal {
    static constexpr bool PERM = false, AFTER_DRAIN = false;
    const bf16_t* base; float* out; const float* g; float* xbuf; unsigned* cnt; PG8_LAS unsigned char* xl;
    __device__ __forceinline__ f32x4 ld_base(size_t off) const { const u32x2 w = *(const u32x2*)(base + off);
        f32x4 b; b[0] = __builtin_bit_cast(float, w.x << 16); b[1] = __builtin_bit_cast(float, w.x & 0xffff0000u); b[2] = __builtin_bit_cast(float, w.y << 16); b[3] = __builtin_bit_cast(float, w.y & 0xffff0000u); return b; }
    __device__ __forceinline__ void operator()(const f32x4 (&acc)[2][2][4][2], const Unit& u, int wr, int wc, int fr, int fq) const {
        const int lane = fr + 16 * fq, wid = wr * 4 + wc;
        PG8_LAS float* P = (PG8_LAS float*)xl; PG8_LAS float* S = (PG8_LAS float*)(xl + 4096);
        const int col0 = u.pn * BM + wc * 32 + 4 * fq;
        const size_t offb = (size_t)(u.pm * BM + wr * 64 + fr) * 1024 + col0;
        f32x4 nb[2][2];
#pragma unroll
        for (int bj = 0; bj < 2; ++bj)
#pragma unroll
            for (int n = 0; n < 2; ++n) nb[bj][n] = ld_base(offb + bj * HALF + n * 16);
#pragma unroll
        for (int gI = 0; gI < 8; ++gI) {
            const int ai = gI >> 2, m = gI & 3, rt = ai * HALF + wr * 64 + m * 16 + fr; float s = 0.f;
            f32x4 cb[2][2];
#pragma unroll
            for (int bj = 0; bj < 2; ++bj)
#pragma unroll
                for (int n = 0; n < 2; ++n) cb[bj][n] = nb[bj][n];
            if (gI < 7) { const size_t offn = offb + (size_t)(((gI + 1) >> 2) * HALF + ((gI + 1) & 3) * 16) * 1024;
#pragma unroll
                for (int bj = 0; bj < 2; ++bj)
#pragma unroll
                    for (int n = 0; n < 2; ++n) nb[bj][n] = ld_base(offn + bj * HALF + n * 16); }
            asm volatile("" ::: "memory");
#pragma unroll
            for (int bj = 0; bj < 2; ++bj)
#pragma unroll
                for (int n = 0; n < 2; ++n) { const f32x4 o = cb[bj][n] + acc[ai][bj][m][n]; s += (o[0] * o[0] + o[1] * o[1]) + (o[2] * o[2] + o[3] * o[3]);
                    const_cast<f32x4&>(acc[ai][bj][m][n]) = o; }
            s = xsum_fq(s);
            if (fq == 0) P[rt * 4 + wc] = s;
        }
        asm volatile("s_waitcnt lgkmcnt(0)" ::: "memory"); __builtin_amdgcn_s_barrier(); asm volatile("" ::: "memory");
        const int row = wid * 32 + (lane & 31);
        if (lane < 32) { const f32x4 p = *(const PG8_LAS f32x4*)(P + row * 4);
            __hip_atomic_store(xbuf + (size_t)(u.pm * BM + row) * 4 + u.pn, (p[0] + p[1]) + (p[2] + p[3]), __ATOMIC_RELAXED, __HIP_MEMORY_SCOPE_AGENT); }
        asm volatile("s_waitcnt vmcnt(0)" ::: "memory");
        if (lane == 0) __hip_atomic_fetch_add(cnt + 64 * u.pm, 1u, __ATOMIC_RELAXED, __HIP_MEMORY_SCOPE_AGENT);
        if (wid == 0) {
            unsigned sp = 0;
            while ((unsigned)__builtin_amdgcn_readfirstlane(__hip_atomic_load(cnt + 64 * u.pm, __ATOMIC_RELAXED, __HIP_MEMORY_SCOPE_AGENT)) < 32u) { __builtin_amdgcn_s_sleep(2); if (++sp > (1u << 22)) break; }
            __builtin_amdgcn_fence(__ATOMIC_ACQUIRE, "agent");
        }
        asm volatile("s_waitcnt vmcnt(0) lgkmcnt(0)" ::: "memory"); __builtin_amdgcn_s_barrier(); asm volatile("" ::: "memory");
        if (lane < 32) { const float* sl = xbuf + (size_t)(u.pm * BM + row) * 4; float t = 0.f;
#pragma unroll
            for (int k = 0; k < 4; ++k) t += __hip_atomic_load(sl + k, __ATOMIC_RELAXED, __HIP_MEMORY_SCOPE_AGENT);
            S[row] = 1.0f / sqrtf(t * (1.0f / 1024.0f) + 1e-5f); }
        asm volatile("s_waitcnt lgkmcnt(0)" ::: "memory"); __builtin_amdgcn_s_barrier(); asm volatile("" ::: "memory");
        f32x4 gv[2][2];
#pragma unroll
        for (int bj = 0; bj < 2; ++bj)
#pragma unroll
            for (int n = 0; n < 2; ++n) gv[bj][n] = *(const f32x4*)(g + col0 + bj * HALF + n * 16);
#pragma unroll
        for (int gI = 0; gI < 8; ++gI) {
            const int ai = gI >> 2, m = gI & 3, rt = ai * HALF + wr * 64 + m * 16 + fr; const size_t off = (size_t)(u.pm * BM + rt) * 1024 + col0; const float rstd = S[rt];
#pragma unroll
            for (int bj = 0; bj < 2; ++bj)
#pragma unroll
                for (int n = 0; n < 2; ++n) { const f32x4 o = acc[ai][bj][m][n] * rstd * gv[bj][n]; *(f32x4*)(out + off + bj * HALF + n * 16) = o; }
        }
    }
};

struct EpiSwiGLU {
    static constexpr bool PERM = true, AFTER_DRAIN = false;
    bf16_t* O; const float* ssqp; int ldc;
    __device__ __forceinline__ void operator()(const f32x4 (&acc)[2][2][4][2], const Unit& u, int wr, int wc, int fr, int fq) const {
        const int row0 = u.pm * BM + wr * 64 + fr, col0 = u.pn * HALF + wc * 32 + 8 * fq;
        f32x4 pr[8];
#pragma unroll
        for (int gI = 0; gI < 8; ++gI) pr[gI] = *(const f32x4*)(ssqp + (size_t)(row0 + (gI >> 2) * HALF + (gI & 3) * 16) * 16 + 4 * fq);
        float rv[8];
#pragma unroll
        for (int gI = 0; gI < 8; ++gI) { float t = (pr[gI][0] + pr[gI][1]) + (pr[gI][2] + pr[gI][3]); t = xsum_fq(t); rv[gI] = __builtin_amdgcn_rsqf(t * (1.0f / 1024.0f) + 1e-5f); }
#pragma unroll
        for (int ai = 0; ai < 2; ++ai)
#pragma unroll
            for (int m = 0; m < 4; ++m) {
                const int row = row0 + ai * HALF + m * 16;
                const float r = rv[ai * 4 + m], rneg = r * -1.4426950408889634f, r2 = r * r;
                float o[8];
#pragma unroll
                for (int n = 0; n < 2; ++n)
#pragma unroll
                    for (int j = 0; j < 4; j += 2) {
                        const f32x2 g = {acc[ai][0][m][n][j], acc[ai][0][m][n][j + 1]}, up = {acc[ai][1][m][n][j], acc[ai][1][m][n][j + 1]};
                        const f32x2 t = g * up, x = g * rneg;
                        f32x2 e; e.x = __builtin_amdgcn_exp2f(x.x); e.y = __builtin_amdgcn_exp2f(x.y);
                        const f32x2 d = e + 1.0f; f32x2 q; q.x = __builtin_amdgcn_rcpf(d.x); q.y = __builtin_amdgcn_rcpf(d.y);
                        const f32x2 y = t * (q * r2);
                        o[n * 4 + j] = y.x; o[n * 4 + j + 1] = y.y;
                    }
                u32x4 w; w.x = cvt_pk_bf16(o[0], o[1]); w.y = cvt_pk_bf16(o[2], o[3]); w.z = cvt_pk_bf16(o[4], o[5]); w.w = cvt_pk_bf16(o[6], o[7]);
                __builtin_nontemporal_store(w, (u32x4*)(O + (size_t)row * ldc + col0));
            }
    }
};

template <class Epi, class Sched, bool ALIGN_EPI = false, bool SP2 = false>
__device__ __forceinline__ void gemm_phase(PG8_LAS unsigned char* lds, const Gemm g, const Sched& S, const Epi& E) {
    const int tid = opaque_tid(), wid = __builtin_amdgcn_readfirstlane(tid >> 6), lane = tid & 63, wr = wid >> 2, wc = wid & 3, fr = lane & 15, fq = lane >> 4;
    const int K = g.K, nt = K / BK;
    unsigned voffA[2], voffB[2];
#pragma unroll
    for (int i = 0; i < 2; ++i) { int R, C; stage_rc(tid * 16 + i * 8192, R, C); const int Rb = Epi::PERM ? ((R & ~31) + perm32(R & 31)) : R;
        voffA[i] = (unsigned)(R * K + C) * 2u; voffB[i] = (unsigned)(Rb * K + C) * 2u; }
    const size_t kstep = (size_t)(BK * 2);
    const size_t hstep = (size_t)HALF * K * 2;
    const size_t tstep = 2 * hstep;
    const unsigned ldsw = (unsigned)wid * 1024u;
    const int aoff = lds_byte(wr * 64 + fr, fq * 8), boff = lds_byte(wc * 32 + fr, fq * 8);
#define PG8_SA(b, h) (((b) * 2 + (h)) * HTB)
#define PG8_SB(b, h) ((4 + (b) * 2 + (h)) * HTB)
#define PG8_STAGE(bufoff, gbase, voff) do { _Pragma("unroll") for (int _i = 0; _i < 2; ++_i) \
        __builtin_amdgcn_global_load_lds((const unsigned*)((const char*)(gbase) + (voff)[_i]), (PG8_LAS unsigned*)(lds + (bufoff) + ldsw + _i * 8192), 16, 0, 0); } while (0)
#define PG8_LDA(dst, b, h) do { _Pragma("unroll") for (int m = 0; m < 4; ++m) _Pragma("unroll") for (int k = 0; k < 2; ++k) dst[m][k] = *(const PG8_LAS bf16x8*)(lds + PG8_SA(b, h) + aoff + m * 2048 + k * 1024); } while (0)
#define PG8_LDB(dst, b, h) do { _Pragma("unroll") for (int n = 0; n < 2; ++n) _Pragma("unroll") for (int k = 0; k < 2; ++k) dst[n][k] = *(const PG8_LAS bf16x8*)(lds + PG8_SB(b, h) + boff + n * 2048 + k * 1024); } while (0)
#define PG8_MMA(ai, bj, At, Bt) do { __builtin_amdgcn_s_setprio(1); _Pragma("unroll") for (int m = 0; m < 4; ++m) _Pragma("unroll") for (int n = 0; n < 2; ++n) _Pragma("unroll") for (int k = 0; k < 2; ++k) \
        acc[ai][bj][m][n] = __builtin_amdgcn_mfma_f32_16x16x32_bf16(Bt[n][k], At[m][k], acc[ai][bj][m][n], 0, 0, 0); __builtin_amdgcn_s_setprio(0); } while (0)
#define PG8_WAIT_V(n) asm volatile("s_waitcnt vmcnt(" #n ")" ::: "memory")
#define PG8_WAIT_L(n) asm volatile("s_waitcnt lgkmcnt(" #n ")" ::: "memory")
#define PG8_BAR __builtin_amdgcn_s_barrier()
#define PG8_SCHED __builtin_amdgcn_sched_barrier(0)
    Unit cur, nxt; int ui = 0;
    if (!S.next(0, cur)) return;
    f32x4 acc[2][2][4][2];
#pragma unroll
    for (int a = 0; a < 2; ++a)
#pragma unroll
        for (int b = 0; b < 2; ++b)
#pragma unroll
            for (int m = 0; m < 4; ++m)
#pragma unroll
                for (int n = 0; n < 2; ++n) acc[a][b][m][n] = (f32x4){0.f, 0.f, 0.f, 0.f};
    bf16x8 At[4][2], B0[2][2], B1[2][2];
    const char* cA = (const char*)g.A + (size_t)cur.pm * tstep; const char* cB = (const char*)g.Bt + (size_t)cur.pn * tstep;
    S.a_ready(cur);
    if constexpr (SP2) {
        PG8_STAGE(PG8_SB(0, 0), cB, voffB); PG8_STAGE(PG8_SB(0, 1), cB + hstep, voffB); PG8_STAGE(PG8_SA(0, 0), cA, voffA); PG8_STAGE(PG8_SA(0, 1), cA + hstep, voffA);
        if (wr == 1) PG8_BAR;
        PG8_WAIT_V(2); PG8_BAR;
        PG8_STAGE(PG8_SB(1, 0), cB + kstep, voffB); PG8_STAGE(PG8_SA(1, 0), cA + kstep, voffA); PG8_STAGE(PG8_SB(1, 1), cB + hstep + kstep, voffB);
        PG8_WAIT_V(6); PG8_BAR;
    } else {
        PG8_STAGE(PG8_SB(0, 0), cB, voffB); PG8_STAGE(PG8_SA(0, 0), cA, voffA); PG8_STAGE(PG8_SB(0, 1), cB + hstep, voffB); PG8_STAGE(PG8_SA(0, 1), cA + hstep, voffA);
        if (wr == 1) PG8_BAR;
        PG8_WAIT_V(4); PG8_BAR;
        PG8_STAGE(PG8_SB(1, 0), cB + kstep, voffB); PG8_STAGE(PG8_SA(1, 0), cA + kstep, voffA); PG8_STAGE(PG8_SB(1, 1), cB + hstep + kstep, voffB);
        PG8_WAIT_V(6); PG8_BAR;
    }
    for (;;) {
        const bool has_next = S.next(ui + 1, nxt);
        const char* nA = has_next ? (const char*)g.A + (size_t)nxt.pm * tstep : cA; const char* nB = has_next ? (const char*)g.Bt + (size_t)nxt.pn * tstep : cB;
        for (int t = 0; t < nt; t += 2) {
            const bool last = (t == nt - 2);
            const char* a1 = cA + (size_t)(t + 1) * kstep;
            const char* a2 = last ? nA : cA + (size_t)(t + 2) * kstep; const char* b2 = last ? nB : cB + (size_t)(t + 2) * kstep;
            const char* a3 = a2 + kstep; const char* b3 = b2 + kstep;
            if (last && has_next) S.a_ready(nxt);
            if constexpr (SP2) {
            PG8_LDB(B0, 0, 0); PG8_LDB(B1, 0, 1); PG8_SCHED; PG8_LDA(At, 0, 0); PG8_STAGE(PG8_SA(1, 1), a1 + hstep, voffA);
            PG8_WAIT_V(8); PG8_WAIT_L(0); PG8_BAR; PG8_MMA(0, 0, At, B0); PG8_MMA(0, 1, At, B1); PG8_BAR; PG8_SCHED;
            PG8_LDA(At, 0, 1); PG8_STAGE(PG8_SB(0, 0), b2, voffB); PG8_STAGE(PG8_SB(0, 1), b2 + hstep, voffB); PG8_STAGE(PG8_SA(0, 0), a2, voffA);
            PG8_WAIT_V(8); PG8_WAIT_L(0); PG8_BAR; PG8_MMA(1, 0, At, B0); PG8_MMA(1, 1, At, B1); PG8_BAR; PG8_SCHED;
            PG8_LDB(B0, 1, 0); PG8_LDB(B1, 1, 1); PG8_SCHED; PG8_LDA(At, 1, 0); PG8_STAGE(PG8_SA(0, 1), a2 + hstep, voffA);
            PG8_WAIT_V(8); PG8_WAIT_L(0); PG8_BAR; PG8_MMA(0, 0, At, B0); PG8_MMA(0, 1, At, B1); PG8_BAR; PG8_SCHED;
            PG8_LDA(At, 1, 1); PG8_STAGE(PG8_SB(1, 0), b3, voffB); PG8_STAGE(PG8_SB(1, 1), b3 + hstep, voffB); PG8_STAGE(PG8_SA(1, 0), a3, voffA);
            PG8_WAIT_V(8); PG8_WAIT_L(0); PG8_BAR; PG8_MMA(1, 0, At, B0); PG8_MMA(1, 1, At, B1); PG8_BAR; PG8_SCHED;
            } else {
            PG8_LDB(B0, 0, 0); PG8_SCHED; PG8_LDA(At, 0, 0); PG8_STAGE(PG8_SA(1, 1), a1 + hstep, voffA);
            PG8_WAIT_L(8); PG8_BAR; PG8_WAIT_L(0); PG8_MMA(0, 0, At, B0); PG8_BAR; PG8_SCHED;
            PG8_LDB(B1, 0, 1); PG8_STAGE(PG8_SB(0, 0), b2, voffB);
            PG8_BAR; PG8_WAIT_L(0); PG8_MMA(0, 1, At, B1); PG8_BAR;
            PG8_LDA(At, 0, 1); PG8_STAGE(PG8_SA(0, 0), a2, voffA);
            PG8_BAR; PG8_WAIT_L(0); PG8_MMA(1, 0, At, B0); PG8_BAR; PG8_SCHED;
            PG8_STAGE(PG8_SB(0, 1), b2 + hstep, voffB);
            PG8_WAIT_V(6); PG8_BAR; PG8_MMA(1, 1, At, B1); PG8_BAR;
            PG8_LDB(B0, 1, 0); PG8_SCHED; PG8_LDA(At, 1, 0); PG8_STAGE(PG8_SA(0, 1), a2 + hstep, voffA);
            PG8_WAIT_L(8); PG8_BAR; PG8_WAIT_L(0); PG8_MMA(0, 0, At, B0); PG8_BAR; PG8_SCHED;
            PG8_LDB(B1, 1, 1); PG8_STAGE(PG8_SB(1, 0), b3, voffB);
            PG8_BAR; PG8_WAIT_L(0); PG8_MMA(0, 1, At, B1); PG8_BAR;
            PG8_LDA(At, 1, 1); PG8_STAGE(PG8_SA(1, 0), a3, voffA);
            PG8_BAR; PG8_WAIT_L(0); PG8_MMA(1, 0, At, B0); PG8_BAR; PG8_SCHED;
            PG8_STAGE(PG8_SB(1, 1), b3 + hstep, voffB);
            PG8_WAIT_V(6); PG8_BAR; PG8_MMA(1, 1, At, B1); PG8_BAR;
            }
        }
        if constexpr (ALIGN_EPI) { if (wr == 0) PG8_BAR; }
        if constexpr (!Epi::AFTER_DRAIN) { E(acc, cur, wr, wc, fr, fq); S.done(cur); }
        if (!has_next) break;
#pragma unroll
        for (int a = 0; a < 2; ++a)
#pragma unroll
            for (int b = 0; b < 2; ++b)
#pragma unroll
                for (int m = 0; m < 4; ++m)
#pragma unroll
                    for (int n = 0; n < 2; ++n) acc[a][b][m][n] = (f32x4){0.f, 0.f, 0.f, 0.f};
        cur = nxt; cA = nA; cB = nB; ++ui;
        if constexpr (ALIGN_EPI) { if (wr == 1) PG8_BAR; }
    }
    PG8_WAIT_V(0);
    if constexpr (!ALIGN_EPI) { if (wr == 0) PG8_BAR; }
    PG8_BAR;
    if constexpr (Epi::AFTER_DRAIN) { E.fused(acc, cur, wr, wc, fr, fq, lds, wid, lane); S.done(cur); }
#undef PG8_SA
#undef PG8_SB
#undef PG8_STAGE
#undef PG8_LDA
#undef PG8_LDB
#undef PG8_MMA
#undef PG8_WAIT_V
#undef PG8_WAIT_L
#undef PG8_BAR
#undef PG8_SCHED
}
}
namespace attn_body {
using bf16=__hip_bfloat16;
using bf16x8=__attribute__((ext_vector_type(8)))short;
using s16x4=__attribute__((ext_vector_type(4)))short;
using f32x16=__attribute__((ext_vector_type(16)))float;
using u32x4=__attribute__((ext_vector_type(4)))unsigned;
constexpr int SEQ=2048,D=64,QKVP=3072,OUTP=1024;
constexpr int NW=8,QBLK=32,QB=QBLK*NW,KVBLK=64,NQB=SEQ/QB;

__device__ __forceinline__ int crow(int r,int hi){return (r&3)+8*(r>>2)+4*hi;}
#define SBAR() __builtin_amdgcn_sched_barrier(0)
__device__ __forceinline__ void cmask(f32x16&p0,f32x16&p1,int jb,int qrel,int hi){
  const float NEG=-INFINITY; int kb=64*jb+4*hi;
  #pragma unroll
  for(int r=0;r<16;++r){int kv=kb+(r&3)+8*(r>>2); if(kv>qrel)p0[r]=NEG; if(kv+32>qrel)p1[r]=NEG;}
}

constexpr int NSLOT=3, SLOTB=8192;
constexpr int LDS_K=0, LDS_V=NSLOT*SLOTB, LDS_WS=2*NSLOT*SLOTB, LDS_OST=LDS_WS+NW*64*4, LDS_BYTES=LDS_OST+NW*4096;
constexpr float C2=0.125f*1.4426950408889634f;
__device__ __forceinline__ void glds16(const void*gsrc,unsigned lds_dst){unsigned keep;
  asm volatile("s_mov_b32 %0, m0\n\ts_mov_b32 m0, %2\n\ts_nop 0\n\tglobal_load_lds_dwordx4 %1, off\n\ts_mov_b32 m0, %0":"=&s"(keep):"v"(gsrc),"s"(lds_dst):"memory");}
__device__ __forceinline__ float max3f(float a,float b,float c){float r;asm("v_max3_f32 %0, %1, %2, %3":"=v"(r):"v"(a),"v"(b),"v"(c));return r;}
__device__ __forceinline__ float max2f(float a,float b){float r;asm("v_max_f32_e32 %0, %1, %2":"=v"(r):"v"(a),"v"(b));return r;}
__device__ __forceinline__ float fadd_s(float a,float b){float r;asm("v_add_f32_e32 %0, %1, %2":"=v"(r):"v"(a),"v"(b));return r;}
__device__ __forceinline__ float fsub_s(float a,float b){float r;asm("v_sub_f32_e32 %0, %1, %2":"=v"(r):"v"(a),"v"(b));return r;}
typedef float f32x2_t __attribute__((ext_vector_type(2))); typedef __bf16 bf16x2_t __attribute__((ext_vector_type(2)));
__device__ __forceinline__ unsigned cvtpk_s(float lo,float hi){f32x2_t v={lo,hi};bf16x2_t b=__builtin_convertvector(v,bf16x2_t);return __builtin_bit_cast(unsigned,b);}
#define WAIT_BAR(N) asm volatile("s_waitcnt vmcnt(" #N ") lgkmcnt(0)\n\ts_barrier":::"memory")

__device__ __forceinline__ void qkt(f32x16&p0,f32x16&p1,const char*Kslot,const bf16x8*qr,const f32x16&negm,int r32,int hi){
  const char*kb=Kslot+hi*1024+r32*16;
  #pragma unroll
  for(int d0=0;d0<4;++d0){
    const bf16x8 b0=*reinterpret_cast<const bf16x8*>(kb+d0*2048);
    const bf16x8 b1=*reinterpret_cast<const bf16x8*>(kb+d0*2048+512);
    if(d0==0){p0=__builtin_amdgcn_mfma_f32_32x32x16_bf16(b0,qr[0],negm,0,0,0);p1=__builtin_amdgcn_mfma_f32_32x32x16_bf16(b1,qr[0],negm,0,0,0);}
    else{p0=__builtin_amdgcn_mfma_f32_32x32x16_bf16(b0,qr[d0],p0,0,0,0);p1=__builtin_amdgcn_mfma_f32_32x32x16_bf16(b1,qr[d0],p1,0,0,0);}}
}
typedef __attribute__((address_space(3))) const char* lds_cptr;
typedef short v4i16_t __attribute__((ext_vector_type(4)));
__device__ __forceinline__ void kload8(bf16x8*kf,lds_cptr kp){
  kf[0]=*(const __attribute__((address_space(3))) bf16x8*)(kp);      kf[1]=*(const __attribute__((address_space(3))) bf16x8*)(kp+512);
  kf[2]=*(const __attribute__((address_space(3))) bf16x8*)(kp+2048); kf[3]=*(const __attribute__((address_space(3))) bf16x8*)(kp+2560);
  kf[4]=*(const __attribute__((address_space(3))) bf16x8*)(kp+4096); kf[5]=*(const __attribute__((address_space(3))) bf16x8*)(kp+4608);
  kf[6]=*(const __attribute__((address_space(3))) bf16x8*)(kp+6144); kf[7]=*(const __attribute__((address_space(3))) bf16x8*)(kp+6656);
}
__device__ __forceinline__ void kload2(bf16x8*kf,lds_cptr kp,int j){ kf[2*j]=*(const __attribute__((address_space(3))) bf16x8*)(kp+j*2048); kf[2*j+1]=*(const __attribute__((address_space(3))) bf16x8*)(kp+j*2048+512); }
__device__ __forceinline__ s16x4 vtr(lds_cptr p){ return __builtin_bit_cast(s16x4,__builtin_amdgcn_ds_read_tr16_b64_v4i16((__attribute__((address_space(3))) v4i16_t*)p)); }
__device__ __forceinline__ float rowmax(const f32x16&p0,const f32x16&p1){
  float a=max3f(p0[0],p0[1],p1[0]),b=max3f(p0[2],p0[3],p1[1]);a=max3f(a,p1[2],p1[3]);
  #pragma unroll
  for(int r=4;r<16;r+=4){a=max3f(a,p0[r],p0[r+1]);b=max3f(b,p0[r+2],p0[r+3]);a=max3f(a,p1[r],p1[r+1]);b=max3f(b,p1[r+2],p1[r+3]);}
  const float m=max2f(a,b);
  auto rr=__builtin_amdgcn_permlane32_swap(__float_as_uint(m),__float_as_uint(m),false,false);
  return max2f(__uint_as_float(rr[0]),__uint_as_float(rr[1]));
}
__device__ __forceinline__ void pv(f32x16*o,int vb,bf16x8 pa0,bf16x8 pa1,bf16x8 pa2,bf16x8 pa3){
  #pragma unroll
  for(int d0=0;d0<2;++d0){s16x4 lo[4],hi[4];
    #pragma unroll
    for(int ks=0;ks<4;++ks){
      asm volatile("ds_read_b64_tr_b16 %0,%1 offset:%c2":"=&v"(lo[ks]):"v"(vb),"i"(d0*4096+ks*1024):"memory");
      asm volatile("ds_read_b64_tr_b16 %0,%1 offset:%c2":"=&v"(hi[ks]):"v"(vb),"i"(d0*4096+ks*1024+512):"memory");}
    asm volatile("s_waitcnt lgkmcnt(0)":::"memory");SBAR();
    #define PK(k) (bf16x8){lo[k][0],lo[k][1],lo[k][2],lo[k][3],hi[k][0],hi[k][1],hi[k][2],hi[k][3]}
    o[d0]=__builtin_amdgcn_mfma_f32_32x32x16_bf16(pa0,PK(0),o[d0],0,0,0);
    o[d0]=__builtin_amdgcn_mfma_f32_32x32x16_bf16(pa1,PK(1),o[d0],0,0,0);
    o[d0]=__builtin_amdgcn_mfma_f32_32x32x16_bf16(pa2,PK(2),o[d0],0,0,0);
    o[d0]=__builtin_amdgcn_mfma_f32_32x32x16_bf16(pa3,PK(3),o[d0],0,0,0);
    #undef PK
  }
}

__device__ __forceinline__ void pv_rm(f32x16*o,int vbA,int vbB,bf16x8 pa0,bf16x8 pa1,bf16x8 pa2,bf16x8 pa3){
  #pragma unroll
  for(int d0=0;d0<2;++d0){s16x4 lo[4],hi[4]; const int vb=d0?vbB:vbA;
    #pragma unroll
    for(int ks=0;ks<4;++ks){
      asm volatile("ds_read_b64_tr_b16 %0,%1 offset:%c2":"=&v"(lo[ks]):"v"(vb),"i"(ks*2048):"memory");
      asm volatile("ds_read_b64_tr_b16 %0,%1 offset:%c2":"=&v"(hi[ks]):"v"(vb),"i"(ks*2048+1024):"memory");}
    asm volatile("s_waitcnt lgkmcnt(0)":::"memory");SBAR();
    #define PK(k) (bf16x8){lo[k][0],lo[k][1],lo[k][2],lo[k][3],hi[k][0],hi[k][1],hi[k][2],hi[k][3]}
    o[d0]=__builtin_amdgcn_mfma_f32_32x32x16_bf16(pa0,PK(0),o[d0],0,0,0);
    o[d0]=__builtin_amdgcn_mfma_f32_32x32x16_bf16(pa1,PK(1),o[d0],0,0,0);
    o[d0]=__builtin_amdgcn_mfma_f32_32x32x16_bf16(pa2,PK(2),o[d0],0,0,0);
    o[d0]=__builtin_amdgcn_mfma_f32_32x32x16_bf16(pa3,PK(3),o[d0],0,0,0);
    #undef PK
  }
}

#ifndef ATTN_STORE16
#define ATTN_STORE16(p,v) (*(u32x4*)(p)=(v))
#endif
template<int THRL> __device__ __forceinline__ void attn_unit(int b,int qb,const bf16*Q,const bf16*__restrict__ K,const bf16*__restrict__ V,bf16*O,char*shm,bool pref_in,bool has_next,long dK,long dV,bf16x8 (&qr)[4],int nqb,long dQ){
  const int tid=opaque_tid(),lane=tid&63,r32=lane&31,hi=lane>>5; const int wid=__builtin_amdgcn_readfirstlane(tid>>6);
  const long rowbase=(long)b*SEQ; const int q0=qb*QB;
  const bf16*Qw=Q+(rowbase+q0+wid*QBLK)*QKVP;
  const bf16*Kh=K,*Vh=V;
  const unsigned lds0=(unsigned)(uintptr_t)shm;
  float*wsf=(float*)(shm+LDS_WS)+wid*64;
  const bf16*ksrc=Kh+wid*512+lane*8;
  const bf16*vsrc=Vh+wid*512+lane*8;
  const unsigned kdst=lds0+LDS_K+wid*1024, vdst=lds0+LDS_V+wid*1024;
  #define DMA_K(t,slot) glds16(ksrc+(long)(t)*4096,(unsigned)__builtin_amdgcn_readfirstlane(kdst+(slot)))
  #define DMA_V(t,slot) glds16(vsrc+(long)(t)*4096,(unsigned)__builtin_amdgcn_readfirstlane(vdst+(slot)))
  const int vb0=(int)(lds0+LDS_V)+((lane>>4)&1)*32+(lane&3)*8+(4*hi+((lane&15)>>2))*64;
  const char*Kbase=shm+LDS_K; bf16x8 kf[8];
  const lds_cptr shm3=(lds_cptr)shm; const lds_cptr kp0=shm3+LDS_K+hi*1024+r32*16; const lds_cptr vp0=shm3+LDS_V+((lane>>4)&1)*32+(lane&3)*8+(4*hi+((lane&15)>>2))*64;
  const int NT=(q0+QB)/KVBLK;
  if(!pref_in){DMA_K(0,0);DMA_V(0,0);DMA_K(1,SLOTB);}
  if(!pref_in){
  #pragma unroll
  for(int d0=0;d0<4;++d0)qr[d0]=*reinterpret_cast<const bf16x8*>(&Qw[(long)r32*QKVP+d0*16+hi*8]); }
  float mhat=0.f,l_reg=0.f;f32x16 o[2];o[0]=f32x16{};o[1]=f32x16{};f32x16 negm=f32x16{};asm volatile("":"+v"(negm));
  const int qrel=wid*QBLK+r32;
  #define CMASK(P0,P1,t) do{int jb_=(t)-(NT-4); if(jb_>=0)cmask(P0,P1,jb_,qrel,hi);}while(0)
  bool resc=false;
  #define START(P0,P1) do{ const float rm=rowmax(P0,P1); resc=false; \
    { const float dl=rm; mhat=fadd_s(mhat,dl); \
      _Pragma("unroll") for(int r=0;r<16;++r){P0[r]=fsub_s(P0[r],dl);P1[r]=fsub_s(P1[r],dl);} \
      _Pragma("unroll") for(int r=0;r<16;++r)negm[r]=-mhat; asm volatile("":"+v"(negm)); } \
    _Pragma("unroll") for(int r=0;r<16;++r)P0[r]=__builtin_amdgcn_exp2f(P0[r]); }while(0)
  #define RESC() do{ if(resc){ asm volatile("s_waitcnt lgkmcnt(0)":::"memory"); \
      _Pragma("unroll") for(int d_=0;d_<2;++d_) _Pragma("unroll") for(int r=0;r<16;++r)o[d_][r]*=wsf[crow(r,hi)]; } }while(0)
  f32x16 pA0,pA1,pB0,pB1;
  int sl_prev=0,sl_cur=0,sl_next=SLOTB;
  #define ROT() do{sl_prev=sl_cur;sl_cur=sl_next;sl_next=(sl_next==(NSLOT-1)*SLOTB)?0:sl_next+SLOTB;}while(0)
  DMA_K(2,2*SLOTB);
  WAIT_BAR(3);
  qkt(pA0,pA1,Kbase,qr,negm,r32,hi);asm volatile("s_nop 15\n\ts_nop 7":"+v"(pA0),"+v"(pA1));CMASK(pA0,pA1,0);
  START(pA0,pA1);
  _Pragma("unroll") for(int r=0;r<16;++r)pA1[r]=__builtin_amdgcn_exp2f(pA1[r]);
  WAIT_BAR(0);
  DMA_K(3,0);DMA_V(1,SLOTB);
  ROT();
  kload8(kf,kp0+sl_cur);
  WAIT_BAR(2);
  s16x4 vlo[8],vhi[8]; u32x4 pw0,pw1,pw2,pw3;
  #define PKW(P,B) cvtpk_s(P[B],P[B+1])
  #define PAF(k) __builtin_bit_cast(bf16x8,pw##k)
  #define VFR(i) (bf16x8){vlo[i][0],vlo[i][1],vlo[i][2],vlo[i][3],vhi[i][0],vhi[i][1],vhi[i][2],vhi[i][3]}
  #define PIN(x) asm volatile("":"+v"(x))
  #define MX3(a,b,c) __builtin_fmaxf(__builtin_fmaxf((a),(b)),(c))
  #define GAPA(MF,A0,A1,A2,A3,W0,W1,PW) do{ MF; sacc+=A0; sacc+=A1; sacc+=A2; sacc+=A3; PIN(sacc); W0; W1; PIN(PW); SBAR(); }while(0)
  #define EX(v) __builtin_amdgcn_exp2f(v)
  #define GAPB(MF,X,B) do{ MF; X[B]=EX(X[B]); X[B+1]=EX(X[B+1]); X[B+2]=EX(X[B+2]); X[B+3]=EX(X[B+3]); PIN(X); SBAR(); }while(0)
  #define VRD(i) do{ vlo[i]=vtr(vp_+(((i)>>2)*4096+((i)&3)*1024)); vhi[i]=vtr(vp_+(((i)>>2)*4096+((i)&3)*1024+512)); }while(0)
  #define KRD(G,j) do{ if(G){ kload2(kf,kp0+sl_next,j); SBAR(); } }while(0)
  #define STEP(C0,C1,P0,P1,t,GK,GV,GL) do{ SBAR(); \
    const lds_cptr vp_=vp0+sl_prev; \
    VRD(0); SBAR(); float sacc=(P0[0]+P0[1]); \
    GAPA(C0=__builtin_amdgcn_mfma_f32_32x32x16_bf16(kf[0],qr[0],negm,0,0,0), P0[2],P0[3],P0[4],P0[5],     pw0[0]=PKW(P0,0), pw0[1]=PKW(P0,2), pw0); \
    VRD(4); SBAR(); GAPA(C1=__builtin_amdgcn_mfma_f32_32x32x16_bf16(kf[1],qr[0],negm,0,0,0), P0[6],P0[7],P0[8],P0[9],     pw0[2]=PKW(P0,4), pw0[3]=PKW(P0,6), pw0); \
    VRD(1); SBAR(); GAPA(C0=__builtin_amdgcn_mfma_f32_32x32x16_bf16(kf[2],qr[1],C0,0,0,0),   P0[10],P0[11],P0[12],P0[13], pw1[0]=PKW(P0,8), pw1[1]=PKW(P0,10), pw1); \
    VRD(5); SBAR(); GAPA(C1=__builtin_amdgcn_mfma_f32_32x32x16_bf16(kf[3],qr[1],C1,0,0,0),   P0[14],P0[15],P1[0],P1[1],   pw1[2]=PKW(P0,12),pw1[3]=PKW(P0,14), pw1); \
    VRD(2); SBAR(); GAPA(C0=__builtin_amdgcn_mfma_f32_32x32x16_bf16(kf[4],qr[2],C0,0,0,0),   P1[2],P1[3],P1[4],P1[5],     pw2[0]=PKW(P1,0), pw2[1]=PKW(P1,2), pw2); \
    VRD(6); SBAR(); GAPA(C1=__builtin_amdgcn_mfma_f32_32x32x16_bf16(kf[5],qr[2],C1,0,0,0),   P1[6],P1[7],P1[8],P1[9],     pw2[2]=PKW(P1,4), pw2[3]=PKW(P1,6), pw2); \
    VRD(3); SBAR(); GAPA(C0=__builtin_amdgcn_mfma_f32_32x32x16_bf16(kf[6],qr[3],C0,0,0,0),   P1[10],P1[11],P1[12],P1[13], pw3[0]=PKW(P1,8), pw3[1]=PKW(P1,10), pw3); \
    VRD(7); SBAR(); GAPA(C1=__builtin_amdgcn_mfma_f32_32x32x16_bf16(kf[7],qr[3],C1,0,0,0),   P1[14],P1[15],0.f,0.f,       pw3[2]=PKW(P1,12),pw3[3]=PKW(P1,14), pw3); \
    l_reg+=sacc; \
    if(GK){DMA_K((t)+3,sl_cur);} if(GV){DMA_V((t)+1,sl_next);} \
    CMASK(C0,C1,t); \
    { float a=MX3(C0[0],C0[1],C1[0]),b=MX3(C0[2],C0[3],C1[1]); a=MX3(a,C1[2],C1[3]); \
      _Pragma("unroll") for(int r=4;r<16;r+=4){a=MX3(a,C0[r],C0[r+1]);b=MX3(b,C0[r+2],C0[r+3]);a=MX3(a,C1[r],C1[r+1]);b=MX3(b,C1[r+2],C1[r+3]);} \
      float rm=__builtin_fmaxf(a,b); { auto rr=__builtin_amdgcn_permlane32_swap(__float_as_uint(rm),__float_as_uint(rm),false,false); rm=__builtin_fmaxf(__uint_as_float(rr[0]),__uint_as_float(rr[1])); } \
      resc=false; \
      if(__builtin_expect(__any(rm>(float)THRL),0)){ const float dl=__builtin_fmaxf(rm,0.f); mhat+=dl; \
        _Pragma("unroll") for(int r=0;r<16;++r){C0[r]-=dl;C1[r]-=dl;} \
        _Pragma("unroll") for(int r=0;r<16;++r)negm[r]=-mhat; asm volatile("":"+v"(negm)); \
        const float f=__builtin_amdgcn_exp2f(-dl); l_reg*=f; if(hi==0)wsf[r32]=f; resc=true; } } \
    SBAR(); \
    GAPB(o[0]=__builtin_amdgcn_mfma_f32_32x32x16_bf16(PAF(0),VFR(0),o[0],0,0,0), C0,0); \
    GAPB(o[1]=__builtin_amdgcn_mfma_f32_32x32x16_bf16(PAF(0),VFR(4),o[1],0,0,0), C0,4); \
    KRD(GL,0); GAPB(o[0]=__builtin_amdgcn_mfma_f32_32x32x16_bf16(PAF(1),VFR(1),o[0],0,0,0), C0,8); \
    KRD(GL,1); GAPB(o[1]=__builtin_amdgcn_mfma_f32_32x32x16_bf16(PAF(1),VFR(5),o[1],0,0,0), C0,12); \
    KRD(GL,2); GAPB(o[0]=__builtin_amdgcn_mfma_f32_32x32x16_bf16(PAF(2),VFR(2),o[0],0,0,0), C1,0); \
    KRD(GL,3); GAPB(o[1]=__builtin_amdgcn_mfma_f32_32x32x16_bf16(PAF(2),VFR(6),o[1],0,0,0), C1,4); \
    GAPB(o[0]=__builtin_amdgcn_mfma_f32_32x32x16_bf16(PAF(3),VFR(3),o[0],0,0,0), C1,8); \
    GAPB(o[1]=__builtin_amdgcn_mfma_f32_32x32x16_bf16(PAF(3),VFR(7),o[1],0,0,0), C1,12); \
    }while(0)
  int t=1;
  #undef CMASK
  #define CMASK(P0,P1,t) do{}while(0)
  for(;t+5<NT;t+=2){
    STEP(pB0,pB1,pA0,pA1,t,true,true,true);     WAIT_BAR(2); RESC(); ROT();
    STEP(pA0,pA1,pB0,pB1,t+1,true,true,true);   WAIT_BAR(2); RESC(); ROT();
  }
  #undef CMASK
  #define CMASK(P0,P1,t) do{int jb_=(t)-(NT-4); if(jb_>=0)cmask(P0,P1,jb_,qrel,hi);}while(0)
  #define ENDW(tt) do{ if((tt)+3<NT){WAIT_BAR(2);} else if((tt)+2<NT){WAIT_BAR(1);} else {WAIT_BAR(0);} }while(0)
  for(;t+1<NT;t+=2){
    STEP(pB0,pB1,pA0,pA1,t,(t+3<NT),(t+1<NT),(t+1<NT));       ENDW(t);   RESC(); ROT();
    STEP(pA0,pA1,pB0,pB1,t+1,(t+4<NT),(t+2<NT),(t+2<NT));     ENDW(t+1); RESC(); ROT();
  }
  STEP(pB0,pB1,pA0,pA1,NT-1,false,false,false); RESC();
  { float sacc=pB0[0]+pB0[1]; _Pragma("unroll") for(int r=2;r<16;++r)sacc+=pB0[r]; _Pragma("unroll") for(int r=0;r<16;++r)sacc+=pB1[r]; l_reg+=sacc;
    pw0=(u32x4){PKW(pB0,0),PKW(pB0,2),PKW(pB0,4),PKW(pB0,6)};pw1=(u32x4){PKW(pB0,8),PKW(pB0,10),PKW(pB0,12),PKW(pB0,14)};pw2=(u32x4){PKW(pB1,0),PKW(pB1,2),PKW(pB1,4),PKW(pB1,6)};pw3=(u32x4){PKW(pB1,8),PKW(pB1,10),PKW(pB1,12),PKW(pB1,14)};
    SBAR(); pv(o,vb0+sl_cur,PAF(0),PAF(1),PAF(2),PAF(3)); }
  if(has_next){ asm volatile("s_waitcnt lgkmcnt(0)\n\ts_barrier":::"memory");
    glds16(ksrc+dK,(unsigned)__builtin_amdgcn_readfirstlane(kdst)); glds16(vsrc+dV,(unsigned)__builtin_amdgcn_readfirstlane(vdst)); glds16(ksrc+dK+4096L,(unsigned)__builtin_amdgcn_readfirstlane(kdst+SLOTB));
    const bf16*nQw=Q+dQ+(rowbase+(long)nqb*QB+wid*QBLK)*QKVP;
    #pragma unroll
    for(int d0=0;d0<4;++d0)qr[d0]=*reinterpret_cast<const bf16x8*>(&nQw[(long)r32*QKVP+d0*16+hi*8]); }
  #undef PKW
  #undef PAF
  #undef VFR
  #undef PIN
  #undef MX3
  #undef GAPA
  #undef GAPB
  #undef EX
  #undef VRD
  #undef KRD
  #undef STEP
  #undef ENDW
  {auto rr=__builtin_amdgcn_permlane32_swap(__float_as_uint(l_reg),__float_as_uint(l_reg),false,false);l_reg=__uint_as_float(rr[0])+__uint_as_float(rr[1]);}
  if(hi==0)wsf[32+r32]=l_reg;asm volatile("s_waitcnt lgkmcnt(0)":::"memory");
  float rli[16];
  #pragma unroll
  for(int r=0;r<16;++r)rli[r]=__builtin_amdgcn_rcpf(wsf[32+crow(r,hi)]);
  bf16*Ow=O+(rowbase+q0+wid*QBLK)*OUTP;
  { bf16*stg=(bf16*)(shm+LDS_OST)+wid*2048;
    #pragma unroll
    for(int r=0;r<16;++r){const int orow=crow(r,hi);
      #pragma unroll
      for(int d0=0;d0<2;++d0)stg[orow*64+d0*32+r32]=__float2bfloat16(o[d0][r]*rli[r]);}
    asm volatile("s_waitcnt lgkmcnt(0)":::"memory");
    #pragma unroll
    for(int i=0;i<4;++i){const int row=i*8+(lane>>3),ch=lane&7; const u32x4 v=*(const u32x4*)(stg+row*64+ch*8); ATTN_STORE16(Ow+(long)row*OUTP+ch*8,v);} }
  asm volatile("s_waitcnt lgkmcnt(0)\n\ts_barrier":::"memory");
  #undef DMA_K
  #undef DMA_V
  #undef CMASK
  #undef START
  #undef RESC
  #undef ROT
}
typedef float f32x2_v __attribute__((ext_vector_type(2)));
__device__ __forceinline__ void qkt_rm(f32x16&p0,f32x16&p1,const char*Kslot,const bf16x8*qr,const f32x16&negm,int r32,int hi){
  const char*kb=Kslot+r32*128; const int sw=r32&7;
  #pragma unroll
  for(int d0=0;d0<4;++d0){
    const int off=((2*d0+hi)^sw)*16;
    const bf16x8 b0=*reinterpret_cast<const bf16x8*>(kb+off);
    const bf16x8 b1=*reinterpret_cast<const bf16x8*>(kb+4096+off);
    if(d0==0){p0=__builtin_amdgcn_mfma_f32_32x32x16_bf16(b0,qr[0],negm,0,0,0);p1=__builtin_amdgcn_mfma_f32_32x32x16_bf16(b1,qr[0],negm,0,0,0);}
    else{p0=__builtin_amdgcn_mfma_f32_32x32x16_bf16(b0,qr[d0],p0,0,0,0);p1=__builtin_amdgcn_mfma_f32_32x32x16_bf16(b1,qr[d0],p1,0,0,0);}}
}
__device__ __forceinline__ void sb_block(const char*wl,const bf16x8*qr,bool diag,int qrel,int r32,int hi,float carry,float&ncarry,u32x4&pw0,u32x4&pw1,u32x4&pw2,u32x4&pw3){
    f32x16 p0,p1; const f32x16 zero=f32x16{};
    qkt_rm(p0,p1,wl,qr,zero,r32,hi);
    if(diag){ const int kb=4*hi;
      #pragma unroll
      for(int r=0;r<16;++r){const int kv=kb+(r&3)+8*(r>>2); if(kv>=qrel)p0[r]=-INFINITY; if(kv+32>=qrel)p1[r]=-INFINITY;} }
    f32x2_v R[16];
    #pragma unroll
    for(int r=0;r<16;++r){ f32x2_v z={p0[r],p1[r]}; z=__builtin_elementwise_min(z,(f32x2_v){126.f,126.f});
      f32x2_v e; e.x=__builtin_amdgcn_exp2f(z.x); e.y=__builtin_amdgcn_exp2f(z.y);
      const f32x2_v d=e+1.0f; f32x2_v rc; rc.x=__builtin_amdgcn_rcpf(d.x); rc.y=__builtin_amdgcn_rcpf(d.y);
      R[r]=rc; }
    f32x2_v Gp[4];
    #pragma unroll
    for(int i=0;i<4;++i)Gp[i]=(R[4*i]*R[4*i+1])*(R[4*i+2]*R[4*i+3]);
    float inc[9]; inc[8]=1.0f;
    #pragma unroll
    for(int i=7;i>=0;--i){ const float gp=(i<4)?Gp[i].x:Gp[i-4].y; inc[i]=gp*inc[i+1]; }
    float lo[9],up[8]; lo[8]=1.0f;
    #pragma unroll
    for(int i=0;i<8;++i){ auto rr=__builtin_amdgcn_permlane32_swap(__float_as_uint(inc[i]),__float_as_uint(inc[i]),false,false); lo[i]=__uint_as_float(rr[0]); up[i]=__uint_as_float(rr[1]); }
    ncarry=carry*(lo[0]*up[0]);
    unsigned wx[8],wy[8];
    #pragma unroll
    for(int i=0;i<4;++i){
      f32x2_v l3; l3.x=carry*inc[i+1]*(hi?lo[i+1]:up[i]); l3.y=carry*inc[i+5]*(hi?lo[i+5]:up[i+4]);
      const f32x2_v l2=l3*R[4*i+3], l1=l2*R[4*i+2], l0=l1*R[4*i+1];
      const f32x2_v w0=(1.0f-R[4*i])*l0, w1=(1.0f-R[4*i+1])*l1, w2=(1.0f-R[4*i+2])*l2, w3=(1.0f-R[4*i+3])*l3;
      wx[2*i]=cvtpk_s(w0.x,w1.x); wx[2*i+1]=cvtpk_s(w2.x,w3.x); wy[2*i]=cvtpk_s(w0.y,w1.y); wy[2*i+1]=cvtpk_s(w2.y,w3.y); }
    pw0=(u32x4){wx[0],wx[1],wx[2],wx[3]}; pw1=(u32x4){wx[4],wx[5],wx[6],wx[7]}; pw2=(u32x4){wy[0],wy[1],wy[2],wy[3]}; pw3=(u32x4){wy[4],wy[5],wy[6],wy[7]};
}
__device__ __forceinline__ void sb_item(int b,int gp,const bf16*Q,const bf16*__restrict__ K,const bf16*__restrict__ V,bf16*O,const float*__restrict__ gn,char*wl){
  const int tid=opaque_tid(),lane=tid&63,r32=lane&31,hi=lane>>5;
  const long rowbase=(long)b*SEQ; const int q0=gp*2*QBLK;
  const bf16*Qw=Q+(rowbase+q0)*QKVP;
  const bf16*Kh=K+rowbase*QKVP,*Vh=V+rowbase*QKVP;
  const unsigned lds0=(unsigned)__builtin_amdgcn_readfirstlane((unsigned)(uintptr_t)wl);
  const bf16*ksrc=Kh+(long)(lane>>3)*QKVP+(((lane&7)^(lane>>3))*8);
  const bf16*vsrc=Vh+(long)(lane>>3)*QKVP+(((lane&7)^(lane>>3))*8);
  #define DMA_K(t) do{ _Pragma("unroll") for(int c_=0;c_<8;++c_) glds16(ksrc+((long)(t)*KVBLK+8*c_)*QKVP,lds0+c_*1024); }while(0)
  #define DMA_V(t) do{ _Pragma("unroll") for(int w_=0;w_<8;++w_) glds16(vsrc+((long)(t)*KVBLK+8*w_)*QKVP,lds0+8192+w_*1024); }while(0)
  const int rl=4*hi+((lane&15)>>2), c2=2*((lane>>4)&1)+((lane&3)>>1);
  const int vbA=(int)(lds0+8192)+rl*128+(((0+c2)^rl)*16)+(lane&1)*8, vbB=(int)(lds0+8192)+rl*128+(((4+c2)^rl)*16)+(lane&1)*8;
  const int td=gp;
  DMA_K(td);DMA_V(td);
  bf16x8 qa[4],qb_[4];
  #pragma unroll
  for(int d0=0;d0<4;++d0){qa[d0]=*reinterpret_cast<const bf16x8*>(&Qw[(long)r32*QKVP+d0*16+hi*8]); qb_[d0]=*reinterpret_cast<const bf16x8*>(&Qw[(long)(32+r32)*QKVP+d0*16+hi*8]);}
  asm volatile("s_waitcnt vmcnt(0)":::"memory"); asm volatile("":"+v"(qa[0]),"+v"(qa[1]),"+v"(qa[2]),"+v"(qa[3]),"+v"(qb_[0]),"+v"(qb_[1]),"+v"(qb_[2]),"+v"(qb_[3]));
  f32x16 oa[2],ob[2];oa[0]=f32x16{};oa[1]=f32x16{};ob[0]=f32x16{};ob[1]=f32x16{};
  float ca=1.0f,cb=1.0f;
  for(int t=td;;--t){
    asm volatile("s_waitcnt vmcnt(8)":::"memory");
    float na,nb; u32x4 a0,a1,a2,a3,b0,b1,b2,b3;
    sb_block(wl,qa,t==td,r32,r32,hi,ca,na,a0,a1,a2,a3);
    SBAR();
    sb_block(wl,qb_,t==td,32+r32,r32,hi,cb,nb,b0,b1,b2,b3);
    const bool done=(t==0)||__all(__builtin_fmaxf(na,nb)<7.5e-37f);
    asm volatile("s_waitcnt lgkmcnt(0)":::"memory");
    if(!done)DMA_K(t-1);
    if(done) asm volatile("s_waitcnt vmcnt(0)":::"memory"); else asm volatile("s_waitcnt vmcnt(8)":::"memory");
    SBAR();
    pv_rm(oa,vbA,vbB,__builtin_bit_cast(bf16x8,a0),__builtin_bit_cast(bf16x8,a1),__builtin_bit_cast(bf16x8,a2),__builtin_bit_cast(bf16x8,a3));
    pv_rm(ob,vbA,vbB,__builtin_bit_cast(bf16x8,b0),__builtin_bit_cast(bf16x8,b1),__builtin_bit_cast(bf16x8,b2),__builtin_bit_cast(bf16x8,b3));
    if(done)break;
    DMA_V(t-1);
    ca=na;cb=nb;
  }
  { float*stg=(float*)wl;
    #pragma unroll
    for(int r=0;r<16;++r){const int orow=crow(r,hi);
      #pragma unroll
      for(int d0=0;d0<2;++d0){stg[orow*64+d0*32+r32]=oa[d0][r]; stg[(32+orow)*64+d0*32+r32]=ob[d0][r];}}
    asm volatile("s_waitcnt lgkmcnt(0)":::"memory");
    bf16*Ow=O+(rowbase+q0)*OUTP;
    typedef float f32x4_t __attribute__((ext_vector_type(4)));
    const int ch=lane&7; const f32x4_t g0=*(const f32x4_t*)(gn+ch*8), g1=*(const f32x4_t*)(gn+ch*8+4);
    #pragma unroll
    for(int i=0;i<8;++i){const int row=i*8+(lane>>3);
      const f32x4_t a=*(const f32x4_t*)(stg+row*64+ch*8), c=*(const f32x4_t*)(stg+row*64+ch*8+4);
      float ss=((a[0]*a[0]+a[1]*a[1])+(a[2]*a[2]+a[3]*a[3]))+((c[0]*c[0]+c[1]*c[1])+(c[2]*c[2]+c[3]*c[3]));
      ss+=__shfl_xor(ss,1); ss+=__shfl_xor(ss,2); ss+=__shfl_xor(ss,4);
      const float rstd=1.0f/sqrtf(ss*(1.0f/64.0f)+1e-5f);
      const f32x4_t ya=a*rstd*g0, yc=c*rstd*g1;
      const u32x4 v=(u32x4){cvtpk_s(ya[0],ya[1]),cvtpk_s(ya[2],ya[3]),cvtpk_s(yc[0],yc[1]),cvtpk_s(yc[2],yc[3])};
      *(u32x4*)(Ow+(long)row*OUTP+ch*8)=v; }
    asm volatile("s_waitcnt lgkmcnt(0)":::"memory"); }
  #undef DMA_K
  #undef DMA_V
}
constexpr int ATTN_LDS_BYTES=LDS_BYTES>NW*16384?LDS_BYTES:NW*16384;
#undef SBAR
#undef WAIT_BAR
}
namespace cg = cooperative_groups;
constexpr int NWAVES = 8;
constexpr int BATCH = 32, SEQ = 2048, DMODEL = 1024, INCOLS = 3072, DFF = 2816;
constexpr int M = BATCH * SEQ;
constexpr float EPS = 1e-5f;
constexpr float LAMBDA_INIT = 0.2f;
constexpr size_t MiB = 1u << 20;
constexpr size_t WS_RS0 = 512 * 1024;
constexpr size_t WS_SSQ1 = 34 * MiB, WS_SSQ2 = 38 * MiB;
constexpr size_t WS_BAR = 1 * MiB;
constexpr size_t WS_CNT = 42 * MiB, WS_XBUF = 44 * MiB;
constexpr size_t WS_ROPE = 2 * MiB;
constexpr size_t WS_WIN = 8 * MiB, WS_WOUT = 14 * MiB, WS_WGU = 16 * MiB, WS_WD = 27 * MiB;
constexpr size_t WS_XB = 64 * MiB;
constexpr size_t WS_PROJ = 192 * MiB;
constexpr size_t WS_MIX = 576 * MiB;
constexpr size_t WS_X1B = 704 * MiB;
constexpr size_t WS_KT = 832 * MiB, WS_VT = 896 * MiB;
constexpr size_t WS_END = 960 * MiB;
constexpr int RING_BYTES = 131072, MISC_OFF = RING_BYTES + 256, LDS_BYTES = 147456;
static_assert(attn_body::ATTN_LDS_BYTES <= RING_BYTES, "attention scratch fits the stage-buffer region");

#define GAS __attribute__((address_space(1)))
#define LAS __attribute__((address_space(3)))
typedef unsigned short bf16;
typedef unsigned v4u __attribute__((ext_vector_type(4)));
typedef float f32x4 __attribute__((ext_vector_type(4)));
__device__ __forceinline__ unsigned f2bf(float f) { unsigned u = __builtin_bit_cast(unsigned, f); return (u + 0x7fffu + ((u >> 16) & 1u)) >> 16; }
__device__ __forceinline__ unsigned pk2(float lo, float hi) { return f2bf(lo) | (f2bf(hi) << 16); }
__device__ __forceinline__ float wave_sum(float v) {
#pragma unroll
    for (int o = 1; o < 64; o <<= 1) v += __shfl_xor(v, o);
    return v;
}
__device__ __forceinline__ void p0_transpose_item(const float* W, const float* gk, int K, int N, bf16* WT, int mode, LAS float* scr, int item, int lane) {
    const int nblk = N / 32, kb = item / nblk, nb = item % nblk, k0 = 64 * kb, n0 = 32 * nb;
#pragma unroll 8
    for (int i = 0; i < 32; ++i) { const int kk = 2 * i + (lane >> 5); float w = __builtin_nontemporal_load(&W[(size_t)(k0 + kk) * N + n0 + (lane & 31)]); if (gk) w *= gk[k0 + kk]; scr[kk * 33 + (lane & 31)] = w; }
    asm volatile("s_waitcnt lgkmcnt(0)" ::: "memory");
    const int c = lane & 7;
    const int drow0 = (mode == 0 || mode == 3) ? n0 : (n0 / 128) * 256 + (mode - 1) * 128 + (n0 % 128);
    const bool rperm = (mode == 3) && (n0 < 1024) && ((n0 & 63) == 0);
#pragma unroll
    for (int j = 0; j < 4; ++j) { const int n = (lane >> 3) + 8 * j; const LAS float* s = scr + (8 * c) * 33 + n;
        v4u o; o.x = pk2(s[0 * 33], s[1 * 33]); o.y = pk2(s[2 * 33], s[3 * 33]); o.z = pk2(s[4 * 33], s[5 * 33]); o.w = pk2(s[6 * 33], s[7 * 33]);
        const int nd = (rperm && n < 16) ? ((n < 8) ? 2 * n : 2 * (n - 8) + 1) : n;
        *(v4u*)(WT + (size_t)(drow0 + nd) * K + k0 + 8 * c) = o; }
    asm volatile("s_waitcnt lgkmcnt(0)" ::: "memory");
}

typedef GAS unsigned gu32;
#define RLX_AGENT __ATOMIC_RELAXED, __HIP_MEMORY_SCOPE_AGENT
#define XB_TMO      128
#define XB_XCNT(j)  (256  + 64 * (j))
#define XB_XSUB(j)  (1280 + 64 * (j))
#define XB_XGEN(j)  (2304 + 64 * (j))
#define XB_TOP      3328
#define XB_TOPGEN   3392
#define XCD_BAR_WORDS 3456
#define SBQ_WORD0 3584
#define CTL_WORDS (SBQ_WORD0 + 8 * 64)
#define XB_SPIN_CAP (1u << 18)

__device__ __forceinline__ unsigned xb_ld(unsigned* p)              { return __hip_atomic_load(p, __ATOMIC_RELAXED, __HIP_MEMORY_SCOPE_AGENT); }
__device__ __forceinline__ unsigned xb_add(unsigned* p, unsigned v) { return __hip_atomic_fetch_add(p, v, __ATOMIC_RELAXED, __HIP_MEMORY_SCOPE_AGENT); }
__device__ __forceinline__ unsigned xb_xcc_id() { return (unsigned)__builtin_amdgcn_s_getreg((3 << 11) | 20) & 0xFu; }
#define XB_SPIN(cond, bar) do { unsigned _sp = 0; while (cond) { __builtin_amdgcn_s_sleep(1); \
    if ((++_sp & 255u) == 0u) { if (xb_ld(&(bar)[XB_TMO])) break; if (_sp > XB_SPIN_CAP) { atomicAdd(&(bar)[XB_TMO], 1u); break; } } } } while (0)

struct XcdBarrier {
    unsigned* bar; unsigned x;
    volatile LAS unsigned* st;
};

__device__ __forceinline__ XcdBarrier xcd_barrier_post(unsigned* bar, volatile LAS unsigned* st) {
    XcdBarrier b; b.bar = bar; b.x = xb_xcc_id(); b.st = st;
    if (threadIdx.x == 0) (void)xb_add(&bar[XB_XCNT(b.x)], 1u);
    return b;
}
__device__ __forceinline__ void xcd_barrier_complete(unsigned* bar, unsigned x, unsigned& nloc, unsigned& nx) {
    const unsigned G = gridDim.x * gridDim.y * gridDim.z;
    unsigned sum, cnt, mine, sp = 0u;
    for (;;) {
        sum = 0u; cnt = 0u; mine = 0u;
#pragma unroll
        for (unsigned j = 0; j < 16; ++j) { const unsigned c = xb_ld(&bar[XB_XCNT(j)]); sum += c; cnt += (c > 0u) ? 1u : 0u; mine = (j == x) ? c : mine; }
        if (sum == G) break;
        __builtin_amdgcn_s_sleep(1);
        if ((++sp & 255u) == 0u) { if (xb_ld(&bar[XB_TMO])) break; if (sp > XB_SPIN_CAP) { atomicAdd(&bar[XB_TMO], 1u); break; } }
    }
    nloc = mine > 0u ? mine : 1u; nx = cnt > 0u ? cnt : 1u;
}

__device__ __forceinline__ void xcd_barrier(const XcdBarrier& b) {
    asm volatile("s_waitcnt vmcnt(0)" ::: "memory");
    __syncthreads();
    if (threadIdx.x == 0) {
        unsigned* bar = b.bar;
        __builtin_amdgcn_s_waitcnt(0);
        unsigned nloc = b.st[0], nx = b.st[1];
        if (nloc == 0u) { xcd_barrier_complete(bar, b.x, nloc, nx); b.st[0] = nloc; b.st[1] = nx; }
        const unsigned old = xb_add(&bar[XB_XSUB(b.x)], 1u);
        const unsigned gen = old / nloc;
        if (old + 1u == (gen + 1u) * nloc) {
            __builtin_amdgcn_fence(__ATOMIC_RELEASE, "agent");
            asm volatile("s_waitcnt vmcnt(0)" ::: "memory");
            const unsigned og = xb_add(&bar[XB_TOP], 1u);
            const unsigned tg = og / nx;
            if (og + 1u == (tg + 1u) * nx) xb_add(&bar[XB_TOPGEN], 1u);
            else XB_SPIN(xb_ld(&bar[XB_TOPGEN]) == tg, bar);
            __builtin_amdgcn_fence(__ATOMIC_ACQUIRE, "agent");
            xb_add(&bar[XB_XGEN(b.x)], 1u);
            asm volatile("s_waitcnt vmcnt(0)" ::: "memory");
        } else {
            XB_SPIN(xb_ld(&bar[XB_XGEN(b.x)]) == gen, bar);
            __builtin_amdgcn_fence(__ATOMIC_ACQUIRE, "agent");
            asm volatile("s_waitcnt vmcnt(0)" ::: "memory");
        }
    }
    __syncthreads();
}

#define CTL_EXIT CTL_WORDS
__device__ unsigned g_ctl[CTL_WORDS + 64];
struct Args { const void* in[16]; float* out; unsigned char* ws; };

__global__ void __launch_bounds__(NWAVES * 64, 2) mega_fwd(Args args) {
    extern __shared__ __attribute__((aligned(16))) unsigned char lds[];
    cg::grid_group grid = cg::this_grid();
    const int G = gridDim.x, bx = blockIdx.x;
    const int vcu = (G % 8 == 0) ? (bx % 8) * (G / 8) + bx / 8 : bx;
    const int NGW = G * NWAVES;
    if (threadIdx.x < 64) ((LAS unsigned*)((LAS unsigned char*)lds + MISC_OFF))[threadIdx.x] = 0u;
    __syncthreads();
    if (gridDim.x == 0x7fffffffu) grid.sync();
    const XcdBarrier xbar = xcd_barrier_post(g_ctl, (volatile LAS unsigned*)((LAS unsigned char*)lds + MISC_OFF) + 8);
#define PHASE_IDS() const int tid = opaque_tid(), lane = tid & 63, wave = __builtin_amdgcn_readfirstlane(tid >> 6), gw = vcu * NWAVES + wave; (void)gw; (void)lane
    unsigned char* ws = args.ws;
    const float* x = (const float*)args.in[0]; const int* pos = (const int*)args.in[1];
    const float* g_attn = (const float*)args.in[2]; const float* w_in = (const float*)args.in[3];
    const float* lq1 = (const float*)args.in[4]; const float* lk1 = (const float*)args.in[5]; const float* lq2 = (const float*)args.in[6]; const float* lk2 = (const float*)args.in[7];
    const float* g_diff = (const float*)args.in[8]; const float* g_sb = (const float*)args.in[9];
    const float* w_out = (const float*)args.in[10]; const float* g_ffn = (const float*)args.in[11];
    const float* w_gate = (const float*)args.in[12]; const float* w_up = (const float*)args.in[13]; const float* w_down = (const float*)args.in[14];
    const float* g_fin = (const float*)args.in[15];
    float* out = args.out;
    float* ssq1 = (float*)(ws + WS_SSQ1); float* ssq2 = (float*)(ws + WS_SSQ2); float* rs0 = (float*)(ws + WS_RS0); float* rope = (float*)(ws + WS_ROPE);
    bf16* Win_t = (bf16*)(ws + WS_WIN); bf16* Wout_t = (bf16*)(ws + WS_WOUT); bf16* Wgu_t = (bf16*)(ws + WS_WGU); bf16* Wd_t = (bf16*)(ws + WS_WD);
    bf16* XB = (bf16*)(ws + WS_XB); bf16* OB = XB; bf16* PROJ = (bf16*)(ws + WS_PROJ); bf16* ACT = PROJ; bf16* MIX = (bf16*)(ws + WS_MIX); bf16* X1B = (bf16*)(ws + WS_X1B); bf16* X2B = MIX;

    {
        PHASE_IDS();
        LAS float* scr = (LAS float*)((LAS unsigned char*)lds + wave * 16384);
        constexpr int I_IN = (DMODEL / 64) * (INCOLS / 32), I_OUT = (DMODEL / 64) * (DMODEL / 32), I_G = (DMODEL / 64) * (DFF / 32), I_D = (DFF / 64) * (DMODEL / 32);
        constexpr int NITEMS = I_IN + I_OUT + 2 * I_G + I_D;
        for (int it = gw; it < NITEMS; it += NGW) {
            int r = it;
            if (r < I_IN) { p0_transpose_item(w_in, g_attn, DMODEL, INCOLS, Win_t, 3, scr, r, lane); continue; } r -= I_IN;
            if (r < I_OUT) { p0_transpose_item(w_out, nullptr, DMODEL, DMODEL, Wout_t, 0, scr, r, lane); continue; } r -= I_OUT;
            if (r < I_G) { p0_transpose_item(w_gate, g_ffn, DMODEL, DFF, Wgu_t, 1, scr, r, lane); continue; } r -= I_G;
            if (r < I_G) { p0_transpose_item(w_up, g_ffn, DMODEL, DFF, Wgu_t, 2, scr, r, lane); continue; } r -= I_G;
            p0_transpose_item(w_down, nullptr, DFF, DMODEL, Wd_t, 0, scr, r, lane);
        }
        if (bx == 1 || G == 1) for (int i = tid; i < M / 256; i += NWAVES * 64) ((unsigned*)(ws + WS_CNT))[64 * i] = 0u;
        for (int m4 = gw; m4 < M / 4; m4 += NGW) {
            const int m = 4 * m4;
            const f32x4* xr = (const f32x4*)(x + (size_t)m * DMODEL) + lane;
            f32x4 v[16]; float sr[4];
#pragma unroll
            for (int j = 0; j < 16; ++j) v[j] = __builtin_nontemporal_load(&xr[64 * j]);
#pragma unroll
            for (int r = 0; r < 4; ++r) { float t = 0.f;
#pragma unroll
                for (int j = 0; j < 4; ++j) { const f32x4 q = v[4 * r + j]; t += (q.x * q.x + q.y * q.y) + (q.z * q.z + q.w * q.w); }
                sr[r] = wave_sum(t); }
            if (lane < 4) { const float t = lane == 0 ? sr[0] : lane == 1 ? sr[1] : lane == 2 ? sr[2] : sr[3]; rs0[m + lane] = 1.0f / sqrtf(t * (1.0f / DMODEL) + EPS); }
            unsigned long long* o8 = (unsigned long long*)(XB + (size_t)m * DMODEL) + lane;
#pragma unroll
            for (int j = 0; j < 16; ++j) o8[64 * j] = (unsigned long long)pk2(v[j].x, v[j].y) | ((unsigned long long)pk2(v[j].z, v[j].w) << 32);
        }
        for (int m8 = gw; m8 < M / 8; m8 += NGW) {
            const int m = 8 * m8 + (lane >> 3), fi = lane & 7;
            const float invf = fi == 0 ? 1.0f : fi == 1 ? 0.19392274474868576f : fi == 2 ? 0.03760603093086393f : fi == 3 ? 0.007292664737217109f
                             : fi == 4 ? 0.001414213562373095f : fi == 5 ? 0.0002742481756762073f : fi == 6 ? 5.318295896944988e-05f : 1.031338537721246e-05f;
            const float angf = (float)pos[m] * invf; const double a = (double)angf;
            const double kq = __builtin_rint(a * 0.63661977236758134308); const double r = a - kq * 1.57079632679489661923; const int q = ((int)kq) & 3;
            const double r2 = r * r;
            const double sn = r * (1.0 + r2 * (-1.0 / 6 + r2 * (1.0 / 120 + r2 * (-1.0 / 5040 + r2 * (1.0 / 362880 + r2 * (-1.0 / 39916800 + r2 * (1.0 / 6227020800.0)))))));
            const double cs = 1.0 + r2 * (-0.5 + r2 * (1.0 / 24 + r2 * (-1.0 / 720 + r2 * (1.0 / 40320 + r2 * (-1.0 / 3628800 + r2 * (1.0 / 479001600.0 + r2 * (-1.0 / 87178291200.0)))))));
            const double c_ = (q == 0) ? cs : (q == 1) ? -sn : (q == 2) ? -cs : sn;
            const double s_ = (q == 0) ? sn : (q == 1) ? cs : (q == 2) ? -sn : -cs;
            rope[(size_t)m * 16 + fi] = (float)c_; rope[(size_t)m * 16 + 8 + fi] = (float)s_;
        }
    }
    xcd_barrier(xbar);

    {
        pg8::Gemm g{XB, Win_t, M, INCOLS, DMODEL}; pg8::StaticOrder S; S.init(M, INCOLS, G, bx);
        pg8::EpiInProj E{PROJ, rs0, rope, (bf16*)(ws + WS_KT), (bf16*)(ws + WS_VT)};
        pg8::gemm_phase<pg8::EpiInProj, pg8::StaticOrder, true, true>((LAS unsigned char*)lds, g, S, E);
    }
    xcd_barrier(xbar);

    {
        for (int job = vcu; job < BATCH * 4 * 2; job += G) {
            const int bh = job >> 1, half = job & 1, b = bh >> 2, h = bh & 3;
            attn_body::bf16x8 qfrag[4];
            for (int p = 0; p < 4; ++p) {
                const int mp = p >> 1, vh = p & 1;
                const attn_body::bf16* Q = (const attn_body::bf16*)PROJ + (h * 2 + mp) * 64;
                const attn_body::bf16* K = (const attn_body::bf16*)(ws + WS_KT) + ((size_t)(b * 8 + h * 2 + mp) << 17);
                const attn_body::bf16* V = (const attn_body::bf16*)(ws + WS_VT) + ((size_t)(b * 8 + h * 2 + vh) << 17);
                attn_body::bf16* O = (attn_body::bf16*)OB + (h * 4 + p) * 64;
                const int np = p + 1, nmp = np >> 1, nvh = np & 1;
                const long dQn = (long)((nmp - mp) * 64), dKn = (long)(nmp - mp) * 131072L, dVn = (long)(nvh - vh) * 131072L;
#define QB_OF(i_) ((i_) == 0 ? 7 - half : (i_) == 1 ? 4 + half : (i_) == 2 ? 3 - half : half)
                for (int i = 0; i < 4; ++i) { const int qb = QB_OF(i);
                    const bool first = (p == 0 && i == 0), last = (p == 3 && i == 3);
                    const int ni = (i + 1) & 3, nqb = QB_OF(ni);
                    attn_body::attn_unit<8>(b, qb, Q, K, V, O, (char*)lds, !first, !last, (i == 3) ? dKn : 0L, (i == 3) ? dVn : 0L, qfrag, nqb, (i == 3) ? dQn : 0L); }
            }
            asm volatile("s_waitcnt vmcnt(0)" ::: "memory"); __syncthreads();
            __builtin_amdgcn_fence(__ATOMIC_ACQUIRE, "agent");
            {
                PHASE_IDS();
                const float s1 = wave_sum(lq1[lane] * lk1[lane]), s2 = wave_sum(lq2[lane] * lk2[lane]);
                const float lam = expf(s1) - expf(s2) + LAMBDA_INIT;
                const int rr = lane >> 4, j = lane & 15, vh = j >> 3, c8 = (j & 7) * 8;
                const f32x4 ga = *(const f32x4*)(g_diff + j * 8), gb = *(const f32x4*)(g_diff + j * 8 + 4);
                for (int i = 0; i < 4; ++i) {
                    const int qb = QB_OF(i);
                    const size_t row0 = (size_t)b * SEQ + qb * 256 + wave * 32;
#pragma unroll 2
                    for (int it = 0; it < 8; ++it) {
                        const size_t m = row0 + it * 4 + rr;
                        const bf16* orow = OB + m * 1024 + (h * 4 + vh) * 64 + c8;
                        const v4u a = *(const v4u*)orow, c = *(const v4u*)(orow + 128);
                        float d[8];
#pragma unroll
                        for (int k = 0; k < 4; ++k) { const unsigned ua = a[k], uc = c[k];
                            d[2 * k] = __builtin_bit_cast(float, ua << 16) - lam * __builtin_bit_cast(float, uc << 16);
                            d[2 * k + 1] = __builtin_bit_cast(float, ua & 0xffff0000u) - lam * __builtin_bit_cast(float, uc & 0xffff0000u); }
                        float ss = 0.f;
#pragma unroll
                        for (int k = 0; k < 8; ++k) ss += d[k] * d[k];
                        ss += __shfl_xor(ss, 1); ss += __shfl_xor(ss, 2); ss += __shfl_xor(ss, 4); ss += __shfl_xor(ss, 8);
                        const float rstd = (1.0f - LAMBDA_INIT) / sqrtf(ss * (1.0f / 128.0f) + EPS);
                        v4u o; o.x = pk2(d[0] * rstd * ga[0], d[1] * rstd * ga[1]); o.y = pk2(d[2] * rstd * ga[2], d[3] * rstd * ga[3]);
                        o.z = pk2(d[4] * rstd * gb[0], d[5] * rstd * gb[1]); o.w = pk2(d[6] * rstd * gb[2], d[7] * rstd * gb[3]);
                        *(v4u*)(MIX + m * 1024 + h * 128 + j * 8) = o;
                    }
                }
            }
        }
        {
            const int wv = __builtin_amdgcn_readfirstlane(opaque_tid() >> 6);
            unsigned* qh = g_ctl + SBQ_WORD0;
            constexpr unsigned QITEMS = (BATCH * 8 / 8) * 32;
            unsigned myq = xbar.x & 7u, steal = 0u;
            unsigned raw = 0u;
            { const int ln = opaque_tid() & 63; if (ln == 0) raw = __hip_atomic_fetch_add(qh + 64 * myq, 1u, __ATOMIC_RELAXED, __HIP_MEMORY_SCOPE_AGENT); raw = (unsigned)__builtin_amdgcn_readfirstlane(raw); }
            for (;;) {
                while (raw >= QITEMS && steal < 8u) {
                    ++steal; if (steal >= 8u) break;
                    myq = (myq + 1u) & 7u;
                    const int ln = opaque_tid() & 63; unsigned r2 = 0u; if (ln == 0) r2 = __hip_atomic_fetch_add(qh + 64 * myq, 1u, __ATOMIC_RELAXED, __HIP_MEMORY_SCOPE_AGENT); raw = (unsigned)__builtin_amdgcn_readfirstlane(r2);
                }
                if (raw >= QITEMS) break;
                const unsigned it = raw, q = myq;
                { const int ln = opaque_tid() & 63; unsigned r2 = 0u; if (ln == 0) r2 = __hip_atomic_fetch_add(qh + 64 * myq, 1u, __ATOMIC_RELAXED, __HIP_MEMORY_SCOPE_AGENT); raw = (unsigned)__builtin_amdgcn_readfirstlane(r2); }
                const int job = (int)(q + 8u * (it >> 5)), gq = (int)(it & 31u), b = job >> 3, h = job & 7;
                const attn_body::bf16* Q = (const attn_body::bf16*)PROJ + 1536 + h * 64;
                const attn_body::bf16* K = (const attn_body::bf16*)PROJ + 2048 + h * 64;
                const attn_body::bf16* V = (const attn_body::bf16*)PROJ + 2560 + h * 64;
                attn_body::bf16* O = (attn_body::bf16*)MIX + 512 + h * 64;
                attn_body::sb_item(b, gq, Q, K, V, O, g_sb, (char*)lds + wv * 16384);
            }
        }
    }
    xcd_barrier(xbar);

    {
        pg8::Gemm g{MIX, Wout_t, M, DMODEL, DMODEL}; pg8::StaticOrder S; S.init(M, DMODEL, G, bx);
        pg8::EpiResid<false> E{x, X1B, ssq1};
        pg8::gemm_phase<pg8::EpiResid<false>, pg8::StaticOrder, true, true>((LAS unsigned char*)lds, g, S, E);
    }
    xcd_barrier(xbar);

    {
        pg8::Gemm g{X1B, Wgu_t, M, 2 * DFF, DMODEL}; pg8::StaticOrder S; S.init(M, 2 * DFF, G, bx);
        pg8::EpiSwiGLU E{ACT, ssq1, DFF};
        pg8::gemm_phase<pg8::EpiSwiGLU, pg8::StaticOrder, true, true>((LAS unsigned char*)lds, g, S, E);
    }
    xcd_barrier(xbar);

    {
        pg8::Gemm g{ACT, Wd_t, M, DMODEL, DFF}; pg8::StaticOrder S; S.init(M, DMODEL, G, bx);
        pg8::EpiFinal E{X1B, out, g_fin, (float*)(ws + WS_XBUF), (unsigned*)(ws + WS_CNT), (LAS unsigned char*)lds + RING_BYTES + 1024};
        pg8::gemm_phase<pg8::EpiFinal, pg8::StaticOrder, true, true>((LAS unsigned char*)lds, g, S, E);
    }
    {
        __syncthreads();
        LAS unsigned* lastf = (LAS unsigned*)((LAS unsigned char*)lds + MISC_OFF) + 16;
        if (threadIdx.x == 0) { const unsigned old = __hip_atomic_fetch_add(g_ctl + CTL_EXIT, 1u, __ATOMIC_ACQ_REL, __HIP_MEMORY_SCOPE_AGENT); *lastf = (old == (unsigned)G - 1u) ? 1u : 0u; }
        __syncthreads();
        if (*lastf) {
            for (int i = threadIdx.x; i < CTL_WORDS + 64; i += NWAVES * 64) __hip_atomic_store(g_ctl + i, 0u, __ATOMIC_RELAXED, __HIP_MEMORY_SCOPE_AGENT);
        }
    }
}

extern "C" void kernel_launch(void* const* d_in, const int* in_sizes, int n_in, void* d_out, int out_size, void* d_ws, size_t ws_size, hipStream_t stream) {
    static int grid = 0;
    if (grid == 0) {
        if (n_in != 16 || in_sizes[0] != M * DMODEL || out_size != M * DMODEL || ws_size < WS_END) { fprintf(stderr, "kernel_launch: unexpected shapes (n_in %d, in0 %d, out %d, ws %zu); nothing launched\n", n_in, n_in > 0 ? in_sizes[0] : -1, out_size, ws_size); grid = -1; return; }
        int dev = 0, cus = 0, per_cu = 0;
        if (hipGetDevice(&dev) != hipSuccess || hipDeviceGetAttribute(&cus, hipDeviceAttributeMultiprocessorCount, dev) != hipSuccess) { grid = -1; return; }
        if (hipFuncSetAttribute((const void*)mega_fwd, hipFuncAttributeMaxDynamicSharedMemorySize, LDS_BYTES) != hipSuccess) { fprintf(stderr, "kernel_launch: hipFuncSetAttribute failed\n"); grid = -1; return; }
        if (hipOccupancyMaxActiveBlocksPerMultiprocessor(&per_cu, (const void*)mega_fwd, NWAVES * 64, LDS_BYTES) != hipSuccess || per_cu < 1) { fprintf(stderr, "kernel_launch: occupancy query reports %d\n", per_cu); per_cu = 1; }
        (void)hipGetLastError();
        grid = cus * per_cu;
    }
    if (grid < 0) return;
    Args a{};
    for (int i = 0; i < 16; ++i) a.in[i] = d_in[i];
    a.out = (float*)d_out; a.ws = (unsigned char*)d_ws;
    void* kargs[] = {&a};
    const hipError_t le = hipLaunchCooperativeKernel((const void*)mega_fwd, dim3(grid), dim3(NWAVES * 64), kargs, LDS_BYTES, stream);
    if (le != hipSuccess) fprintf(stderr, "kernel_launch: cooperative launch failed: %s (grid %d)\n", hipGetErrorName(le), grid);
}
```

```cpp
#include <hip/hip_runtime.h>
#include <hip/hip_cooperative_groups.h>
#include <hip/hip_bf16.h>
#include <cstdio>
#include <cstdint>
#include <cmath>
__device__ __forceinline__ int opaque_tid() { int t = threadIdx.x; asm volatile("" : "+v"(t)); return t; }
namespace pg8 {
#define PG8_LAS __attribute__((address_space(3)))
typedef unsigned short bf16_t;
typedef short bf16x8 __attribute__((ext_vector_type(8)));
typedef float f32x4 __attribute__((ext_vector_type(4)));
typedef unsigned u32x4 __attribute__((ext_vector_type(4)));
constexpr int BM = 256, BK = 64, HALF = 128, HTB = HALF * BK * 2  , STAGE_BYTES = 8 * HTB, NXCD = 8, WGM = 8;

__host__ __device__ __forceinline__ int lds_byte(int r, int c) { const int st = (r >> 4) * 2 + (c >> 5), rr = r & 15, cc = c & 31, ob = rr * 64 + cc * 2; return st * 1024 + (ob ^ (((ob >> 9) & 1) << 5)); }
__host__ __device__ __forceinline__ void stage_rc(int b, int& R, int& C) { const int st = b / 1024, sb = b % 1024, swz = sb ^ (((sb >> 9) & 1) << 5); R = (st >> 1) * 16 + swz / 64; C = (st & 1) * 32 + (swz % 64) / 2; }
__host__ __device__ __forceinline__ int perm32(int rho) { const int n = rho >> 4, i = rho & 15; return 8 * (i >> 2) + 4 * n + (i & 3); }

struct Unit { int pm, pn; };
struct Gemm { const bf16_t* A; const bf16_t* Bt; int M, N, K; };

struct StaticOrder {
    int nM, nN, nwg, G, c;
    __host__ __device__ void init(int M, int N, int G_, int c_) { nM = M / BM; nN = N / BM; nwg = nM * nN; G = G_; c = c_; }
    __host__ __device__ bool next(int i, Unit& u) const {
        const long L = (long)i * G + c; if (L >= nwg) return false;
        int wgid = (int)L; { const int q = nwg / NXCD, r = nwg % NXCD, xcd = wgid % NXCD, off = wgid / NXCD; wgid = (xcd < r ? xcd * (q + 1) : r * (q + 1) + (xcd - r) * q) + off; }
        const int nig = WGM * nN, gid = wgid / nig, fm = gid * WGM, gsz = (nM - fm) < WGM ? (nM - fm) : WGM;
        u.pm = fm + ((wgid % nig) % gsz); u.pn = (wgid % nig) / gsz; return true;
    }
    __device__ __forceinline__ void a_ready(const Unit&) const {}
    __device__ __forceinline__ void done(const Unit&) const {}
};

__device__ __forceinline__ unsigned cvt_pk_bf16(float lo, float hi) { unsigned r; asm volatile("v_cvt_pk_bf16_f32 %0, %1, %2" : "=v"(r) : "v"(lo), "v"(hi)); return r; }
typedef unsigned u32x2 __attribute__((ext_vector_type(2)));
__device__ __forceinline__ float xsum_fq(float s) {
    auto a = __builtin_amdgcn_permlane16_swap(__float_as_uint(s), __float_as_uint(s), false, false); s = __uint_as_float(a[0]) + __uint_as_float(a[1]);
    auto b = __builtin_amdgcn_permlane32_swap(__float_as_uint(s), __float_as_uint(s), false, false); return __uint_as_float(b[0]) + __uint_as_float(b[1]); }
__device__ __forceinline__ float xchg16(float v, int fq) {
    auto a = __builtin_amdgcn_permlane16_swap(__float_as_uint(v), __float_as_uint(v), false, false); return __uint_as_float((fq & 1) ? a[0] : a[1]); }
typedef float f32x2 __attribute__((ext_vector_type(2)));
constexpr float QSCALE = 0.125f * 1.4426950408889634f;

struct EpiInProj {
    static constexpr bool PERM = true, AFTER_DRAIN = false;
    bf16_t* O; const float* rs; const float* rope;
    bf16_t* KT; bf16_t* VT;
    __device__ __forceinline__ bf16_t* dst16(int region, int row, int col) const {
        if (region == 1) { const int cr = col - 512, b = row >> 11, rb = row & 2047; return KT + ((size_t)(b * 8 + (cr >> 6)) << 17) + (rb >> 6) * 4096 + ((cr & 63) >> 3) * 512 + (rb & 63) * 8; }
        if (region == 2) { const int cr = col - 1024, b = row >> 11, rb = row & 2047, r64 = rb & 63, ch = (cr & 63) >> 3;
            return VT + ((size_t)(b * 8 + (cr >> 6)) << 17) + (rb >> 6) * 4096 + ((ch >> 2) * 4 + (r64 >> 4)) * 512 + (r64 & 15) * 32 + (ch & 3) * 8; }
        return O + (size_t)row * 3072 + col; }
    __device__ __forceinline__ void operator()(const f32x4 (&acc)[2][2][4][2], const Unit& u, int wr, int wc, int fr, int fq) const {
        const int row0 = u.pm * BM + wr * 64 + fr, region = u.pn >> 1;
        const bool do_rope = (region < 2) && ((wc & 1) == 0);
        const float sc = (region == 0 || region == 3) ? QSCALE : 1.0f;
        const int col0 = u.pn * BM + wc * 32 + 8 * fq;
        const float sgn = (fq == 0) ? -1.0f : 1.0f;
        float rv[8];
#pragma unroll
        for (int gI = 0; gI < 8; ++gI) rv[gI] = rs[row0 + (gI >> 2) * HALF + (gI & 3) * 16];
        if (do_rope) {
            const int fo = 4 * (fq & 1);
            f32x4 nx[2];
            { const float* rp = rope + (size_t)row0 * 16 + fo; nx[0] = *(const f32x4*)(rp); nx[1] = *(const f32x4*)(rp + 8); }
#pragma unroll
            for (int gI = 0; gI < 8; ++gI) {
                const int ai = gI >> 2, m = gI & 3, row = row0 + ai * HALF + m * 16;
                const f32x4 cs = nx[0], sn = nx[1];
                if (gI < 7) { const float* rp = rope + (size_t)(row0 + ((gI + 1) >> 2) * HALF + ((gI + 1) & 3) * 16) * 16 + fo; nx[0] = *(const f32x4*)(rp); nx[1] = *(const f32x4*)(rp + 8); }
                asm volatile("" ::: "memory");
                const float r = rv[gI] * sc;
#pragma unroll
                for (int bj = 0; bj < 2; ++bj) {
                    f32x4 v0 = acc[ai][bj][m][0] * r, v1 = acc[ai][bj][m][1] * r;
                    if (fq < 2) {
                        const f32x4 a = v0, b = v1;
                        v0[0] = a[0] * cs[0] - a[1] * sn[0]; v0[1] = a[1] * cs[0] + a[0] * sn[0]; v0[2] = a[2] * cs[1] - a[3] * sn[1]; v0[3] = a[3] * cs[1] + a[2] * sn[1];
                        v1[0] = b[0] * cs[2] - b[1] * sn[2]; v1[1] = b[1] * cs[2] + b[0] * sn[2]; v1[2] = b[2] * cs[3] - b[3] * sn[3]; v1[3] = b[3] * cs[3] + b[2] * sn[3];
                    }
                    u32x4 w; w.x = cvt_pk_bf16(v0[0], v0[1]); w.y = cvt_pk_bf16(v0[2], v0[3]); w.z = cvt_pk_bf16(v1[0], v1[1]); w.w = cvt_pk_bf16(v1[2], v1[3]);
                    __builtin_nontemporal_store(w, (u32x4*)dst16(region, row, col0 + bj * HALF));
                }
            }
        } else {
#pragma unroll
            for (int gI = 0; gI < 8; ++gI) {
                const int ai = gI >> 2, m = gI & 3, row = row0 + ai * HALF + m * 16;
                const float r = rv[gI] * sc;
#pragma unroll
                for (int bj = 0; bj < 2; ++bj) {
                    const f32x4 v0 = acc[ai][bj][m][0] * r, v1 = acc[ai][bj][m][1] * r;
                    u32x4 w; w.x = cvt_pk_bf16(v0[0], v0[1]); w.y = cvt_pk_bf16(v0[2], v0[3]); w.z = cvt_pk_bf16(v1[0], v1[1]); w.w = cvt_pk_bf16(v1[2], v1[3]);
                    __builtin_nontemporal_store(w, (u32x4*)dst16(region, row, col0 + bj * HALF));
                }
            }
        }
    }
};

template <bool BASE_BF16> struct EpiResid {
    static constexpr bool PERM = false, AFTER_DRAIN = false;
    const void* base; bf16_t* xb; float* ssqp;
    __device__ __forceinline__ void ld4(f32x4 (&d)[2][2], size_t off) const {
#pragma unroll
        for (int bj = 0; bj < 2; ++bj)
#pragma unroll
            for (int n = 0; n < 2; ++n) {
                if (BASE_BF16) { const u32x2 w = *(const u32x2*)((const bf16_t*)base + off + bj * HALF + n * 16);
                    d[bj][n][0] = __builtin_bit_cast(float, w.x << 16); d[bj][n][1] = __builtin_bit_cast(float, w.x & 0xffff0000u); d[bj][n][2] = __builtin_bit_cast(float, w.y << 16); d[bj][n][3] = __builtin_bit_cast(float, w.y & 0xffff0000u); }
                else d[bj][n] = *(const f32x4*)((const float*)base + off + bj * HALF + n * 16); }
    }
    __device__ __forceinline__ void operator()(const f32x4 (&acc)[2][2][4][2], const Unit& u, int wr, int wc, int fr, int fq) const {
        const int col0 = u.pn * BM + wc * 32 + 4 * fq, rowb = u.pm * BM + wr * 64 + fr;
        f32x4 nb[2][2];
        ld4(nb, (size_t)rowb * 1024 + col0);
#pragma unroll
        for (int gI = 0; gI < 8; ++gI) {
            const int ai = gI >> 2, m = gI & 3, row = rowb + ai * HALF + m * 16; const size_t off = (size_t)row * 1024 + col0; float s = 0.f;
            f32x4 cb[2][2];
#pragma unroll
            for (int bj = 0; bj < 2; ++bj)
#pragma unroll
                for (int n = 0; n < 2; ++n) cb[bj][n] = nb[bj][n];
            if (gI < 7) ld4(nb, (size_t)(rowb + ((gI + 1) >> 2) * HALF + ((gI + 1) & 3) * 16) * 1024 + col0);
            asm volatile("" ::: "memory");
#pragma unroll
            for (int bj = 0; bj < 2; ++bj)
#pragma unroll
                for (int n = 0; n < 2; ++n) {
                    const f32x4 o = cb[bj][n] + acc[ai][bj][m][n];
                    s += (o[0] * o[0] + o[1] * o[1]) + (o[2] * o[2] + o[3] * o[3]);
                    u32x2 w; w.x = cvt_pk_bf16(o[0], o[1]); w.y = cvt_pk_bf16(o[2], o[3]); *(u32x2*)(xb + off + bj * HALF + n * 16) = w;
                }
            s = xsum_fq(s);
            if (fq == 0) ssqp[(size_t)row * 16 + u.pn * 4 + wc] = s;
        }
    }
};
__device__ __forceinline__ float sum16(const float* p) { const f32x4 a = *(const f32x4*)p, b = *(const f32x4*)(p + 4), c = *(const f32x4*)(p + 8), d = *(const f32x4*)(p + 12);
    const f32x4 t = (a + b) + (c + d); return (t[0] + t[1]) + (t[2] + t[3]); }

struct EpiFinal {
    static constexpr bool PERM = false, AFTER_DRAIN = false;
    const bf16_t* base; float* out; const float* g; float* xbuf; unsigned* cnt; PG8_LAS unsigned char* xl;
    __device__ __forceinline__ f32x4 ld_base(size_t off) const { const u32x2 w = *(const u32x2*)(base + off);
        f32x4 b; b[0] = __builtin_bit_cast(float, w.x << 16); b[1] = __builtin_bit_cast(float, w.x & 0xffff0000u); b[2] = __builtin_bit_cast(float, w.y << 16); b[3] = __builtin_bit_cast(float, w.y & 0xffff0000u); return b; }
    __device__ __forceinline__ void operator()(const f32x4 (&acc)[2][2][4][2], const Unit& u, int wr, int wc, int fr, int fq) const {
        const int lane = fr + 16 * fq, wid = wr * 4 + wc;
        PG8_LAS float* P = (PG8_LAS float*)xl; PG8_LAS float* S = (PG8_LAS float*)(xl + 4096);
        const int col0 = u.pn * BM + wc * 32 + 4 * fq;
        const size_t offb = (size_t)(u.pm * BM + wr * 64 + fr) * 1024 + col0;
        f32x4 nb[2][2];
#pragma unroll
        for (int bj = 0; bj < 2; ++bj)
#pragma unroll
            for (int n = 0; n < 2; ++n) nb[bj][n] = ld_base(offb + bj * HALF + n * 16);
#pragma unroll
        for (int gI = 0; gI < 8; ++gI) {
            const int ai = gI >> 2, m = gI & 3, rt = ai * HALF + wr * 64 + m * 16 + fr; float s = 0.f;
            f32x4 cb[2][2];
#pragma unroll
            for (int bj = 0; bj < 2; ++bj)
#pragma unroll
                for (int n = 0; n < 2; ++n) cb[bj][n] = nb[bj][n];
            if (gI < 7) { const size_t offn = offb + (size_t)(((gI + 1) >> 2) * HALF + ((gI + 1) & 3) * 16) * 1024;
#pragma unroll
                for (int bj = 0; bj < 2; ++bj)
#pragma unroll
                    for (int n = 0; n < 2; ++n) nb[bj][n] = ld_base(offn + bj * HALF + n * 16); }
            asm volatile("" ::: "memory");
#pragma unroll
            for (int bj = 0; bj < 2; ++bj)
#pragma unroll
                for (int n = 0; n < 2; ++n) { const f32x4 o = cb[bj][n] + acc[ai][bj][m][n]; s += (o[0] * o[0] + o[1] * o[1]) + (o[2] * o[2] + o[3] * o[3]); }
            s = xsum_fq(s);
            if (fq == 0) P[rt * 4 + wc] = s;
        }
        asm volatile("s_waitcnt lgkmcnt(0)" ::: "memory"); __builtin_amdgcn_s_barrier(); asm volatile("" ::: "memory");
        const int row = wid * 32 + (lane & 31);
        if (lane < 32) { const f32x4 p = *(const PG8_LAS f32x4*)(P + row * 4);
            __hip_atomic_store(xbuf + (size_t)(u.pm * BM + row) * 4 + u.pn, (p[0] + p[1]) + (p[2] + p[3]), __ATOMIC_RELAXED, __HIP_MEMORY_SCOPE_AGENT); }
        asm volatile("s_waitcnt vmcnt(0)" ::: "memory");
        if (lane == 0) __hip_atomic_fetch_add(cnt + 64 * u.pm, 1u, __ATOMIC_RELAXED, __HIP_MEMORY_SCOPE_AGENT);
        if (wid == 0) {
            unsigned sp = 0;
            while ((unsigned)__builtin_amdgcn_readfirstlane(__hip_atomic_load(cnt + 64 * u.pm, __ATOMIC_RELAXED, __HIP_MEMORY_SCOPE_AGENT)) < 32u) { __builtin_amdgcn_s_sleep(2); if (++sp > (1u << 22)) break; }
            __builtin_amdgcn_fence(__ATOMIC_ACQUIRE, "agent");
        }
        asm volatile("s_waitcnt vmcnt(0) lgkmcnt(0)" ::: "memory"); __builtin_amdgcn_s_barrier(); asm volatile("" ::: "memory");
        if (lane < 32) { const float* sl = xbuf + (size_t)(u.pm * BM + row) * 4; float t = 0.f;
#pragma unroll
            for (int k = 0; k < 4; ++k) t += __hip_atomic_load(sl + k, __ATOMIC_RELAXED, __HIP_MEMORY_SCOPE_AGENT);
            S[row] = 1.0f / sqrtf(t * (1.0f / 1024.0f) + 1e-5f); }
        asm volatile("s_waitcnt lgkmcnt(0)" ::: "memory"); __builtin_amdgcn_s_barrier(); asm volatile("" ::: "memory");
        f32x4 gv[2][2];
#pragma unroll
        for (int bj = 0; bj < 2; ++bj)
#pragma unroll
            for (int n = 0; n < 2; ++n) gv[bj][n] = *(const f32x4*)(g + col0 + bj * HALF + n * 16);
#pragma unroll
        for (int bj = 0; bj < 2; ++bj)
#pragma unroll
            for (int n = 0; n < 2; ++n) nb[bj][n] = ld_base(offb + bj * HALF + n * 16);
#pragma unroll
        for (int gI = 0; gI < 8; ++gI) {
            const int ai = gI >> 2, m = gI & 3, rt = ai * HALF + wr * 64 + m * 16 + fr; const size_t off = (size_t)(u.pm * BM + rt) * 1024 + col0; const float rstd = S[rt];
            f32x4 cb[2][2];
#pragma unroll
            for (int bj = 0; bj < 2; ++bj)
#pragma unroll
                for (int n = 0; n < 2; ++n) cb[bj][n] = nb[bj][n];
            if (gI < 7) { const size_t offn = offb + (size_t)(((gI + 1) >> 2) * HALF + ((gI + 1) & 3) * 16) * 1024;
#pragma unroll
                for (int bj = 0; bj < 2; ++bj)
#pragma unroll
                    for (int n = 0; n < 2; ++n) nb[bj][n] = ld_base(offn + bj * HALF + n * 16); }
            asm volatile("" ::: "memory");
#pragma unroll
            for (int bj = 0; bj < 2; ++bj)
#pragma unroll
                for (int n = 0; n < 2; ++n) { const f32x4 o = (cb[bj][n] + acc[ai][bj][m][n]) * rstd * gv[bj][n]; *(f32x4*)(out + off + bj * HALF + n * 16) = o; }
        }
    }
};

struct EpiSwiGLU {
    static constexpr bool PERM = true, AFTER_DRAIN = false;
    bf16_t* O; const float* ssqp; int ldc;
    __device__ __forceinline__ void operator()(const f32x4 (&acc)[2][2][4][2], const Unit& u, int wr, int wc, int fr, int fq) const {
        const int row0 = u.pm * BM + wr * 64 + fr, col0 = u.pn * HALF + wc * 32 + 8 * fq;
        f32x4 pr[8];
#pragma unroll
        for (int gI = 0; gI < 8; ++gI) pr[gI] = *(const f32x4*)(ssqp + (size_t)(row0 + (gI >> 2) * HALF + (gI & 3) * 16) * 16 + 4 * fq);
        float rv[8];
#pragma unroll
        for (int gI = 0; gI < 8; ++gI) { float t = (pr[gI][0] + pr[gI][1]) + (pr[gI][2] + pr[gI][3]); t = xsum_fq(t); rv[gI] = __builtin_amdgcn_rsqf(t * (1.0f / 1024.0f) + 1e-5f); }
#pragma unroll
        for (int ai = 0; ai < 2; ++ai)
#pragma unroll
            for (int m = 0; m < 4; ++m) {
                const int row = row0 + ai * HALF + m * 16;
                const float r = rv[ai * 4 + m], rneg = r * -1.4426950408889634f, r2 = r * r;
                float o[8];
#pragma unroll
                for (int n = 0; n < 2; ++n)
#pragma unroll
                    for (int j = 0; j < 4; j += 2) {
                        const f32x2 g = {acc[ai][0][m][n][j], acc[ai][0][m][n][j + 1]}, up = {acc[ai][1][m][n][j], acc[ai][1][m][n][j + 1]};
                        const f32x2 t = g * up, x = g * rneg;
                        f32x2 e; e.x = __builtin_amdgcn_exp2f(x.x); e.y = __builtin_amdgcn_exp2f(x.y);
                        const f32x2 d = e + 1.0f; f32x2 q; q.x = __builtin_amdgcn_rcpf(d.x); q.y = __builtin_amdgcn_rcpf(d.y);
                        const f32x2 y = t * (q * r2);
                        o[n * 4 + j] = y.x; o[n * 4 + j + 1] = y.y;
                    }
                u32x4 w; w.x = cvt_pk_bf16(o[0], o[1]); w.y = cvt_pk_bf16(o[2], o[3]); w.z = cvt_pk_bf16(o[4], o[5]); w.w = cvt_pk_bf16(o[6], o[7]);
                __builtin_nontemporal_store(w, (u32x4*)(O + (size_t)row * ldc + col0));
            }
    }
};

template <class Epi, class Sched, bool ALIGN_EPI = false, bool SP2 = false>
__device__ __forceinline__ void gemm_phase(PG8_LAS unsigned char* lds, const Gemm g, const Sched& S, const Epi& E) {
    const int tid = opaque_tid(), wid = __builtin_amdgcn_readfirstlane(tid >> 6), lane = tid & 63, wr = wid >> 2, wc = wid & 3, fr = lane & 15, fq = lane >> 4;
    const int K = g.K, nt = K / BK;
    unsigned voffA[2], voffB[2];
#pragma unroll
    for (int i = 0; i < 2; ++i) { int R, C; stage_rc(tid * 16 + i * 8192, R, C); const int Rb = Epi::PERM ? ((R & ~31) + perm32(R & 31)) : R;
        voffA[i] = (unsigned)(R * K + C) * 2u; voffB[i] = (unsigned)(Rb * K + C) * 2u; }
    const size_t kstep = (size_t)(BK * 2);
    const size_t hstep = (size_t)HALF * K * 2;
    const size_t tstep = 2 * hstep;
    const unsigned ldsw = (unsigned)wid * 1024u;
    const int aoff = lds_byte(wr * 64 + fr, fq * 8), boff = lds_byte(wc * 32 + fr, fq * 8);
#define PG8_SA(b, h) (((b) * 2 + (h)) * HTB)
#define PG8_SB(b, h) ((4 + (b) * 2 + (h)) * HTB)
#define PG8_STAGE(bufoff, gbase, voff) do { _Pragma("unroll") for (int _i = 0; _i < 2; ++_i) \
        __builtin_amdgcn_global_load_lds((const unsigned*)((const char*)(gbase) + (voff)[_i]), (PG8_LAS unsigned*)(lds + (bufoff) + ldsw + _i * 8192), 16, 0, 0); } while (0)
#define PG8_LDA(dst, b, h) do { _Pragma("unroll") for (int m = 0; m < 4; ++m) _Pragma("unroll") for (int k = 0; k < 2; ++k) dst[m][k] = *(const PG8_LAS bf16x8*)(lds + PG8_SA(b, h) + aoff + m * 2048 + k * 1024); } while (0)
#define PG8_LDB(dst, b, h) do { _Pragma("unroll") for (int n = 0; n < 2; ++n) _Pragma("unroll") for (int k = 0; k < 2; ++k) dst[n][k] = *(const PG8_LAS bf16x8*)(lds + PG8_SB(b, h) + boff + n * 2048 + k * 1024); } while (0)
#define PG8_MMA(ai, bj, At, Bt) do { __builtin_amdgcn_s_setprio(1); _Pragma("unroll") for (int m = 0; m < 4; ++m) _Pragma("unroll") for (int n = 0; n < 2; ++n) _Pragma("unroll") for (int k = 0; k < 2; ++k) \
        acc[ai][bj][m][n] = __builtin_amdgcn_mfma_f32_16x16x32_bf16(Bt[n][k], At[m][k], acc[ai][bj][m][n], 0, 0, 0); __builtin_amdgcn_s_setprio(0); } while (0)
#define PG8_WAIT_V(n) asm volatile("s_waitcnt vmcnt(" #n ")" ::: "memory")
#define PG8_WAIT_L(n) asm volatile("s_waitcnt lgkmcnt(" #n ")" ::: "memory")
#define PG8_BAR __builtin_amdgcn_s_barrier()
#define PG8_SCHED __builtin_amdgcn_sched_barrier(0)
    Unit cur, nxt; int ui = 0;
    if (!S.next(0, cur)) return;
    f32x4 acc[2][2][4][2];
#pragma unroll
    for (int a = 0; a < 2; ++a)
#pragma unroll
        for (int b = 0; b < 2; ++b)
#pragma unroll
            for (int m = 0; m < 4; ++m)
#pragma unroll
                for (int n = 0; n < 2; ++n) acc[a][b][m][n] = (f32x4){0.f, 0.f, 0.f, 0.f};
    bf16x8 At[4][2], B0[2][2], B1[2][2];
    const char* cA = (const char*)g.A + (size_t)cur.pm * tstep; const char* cB = (const char*)g.Bt + (size_t)cur.pn * tstep;
    S.a_ready(cur);
    if constexpr (SP2) {
        PG8_STAGE(PG8_SB(0, 0), cB, voffB); PG8_STAGE(PG8_SB(0, 1), cB + hstep, voffB); PG8_STAGE(PG8_SA(0, 0), cA, voffA); PG8_STAGE(PG8_SA(0, 1), cA + hstep, voffA);
        if (wr == 1) PG8_BAR;
        PG8_WAIT_V(2); PG8_BAR;
        PG8_STAGE(PG8_SB(1, 0), cB + kstep, voffB); PG8_STAGE(PG8_SA(1, 0), cA + kstep, voffA); PG8_STAGE(PG8_SB(1, 1), cB + hstep + kstep, voffB);
        PG8_WAIT_V(6); PG8_BAR;
    } else {
        PG8_STAGE(PG8_SB(0, 0), cB, voffB); PG8_STAGE(PG8_SA(0, 0), cA, voffA); PG8_STAGE(PG8_SB(0, 1), cB + hstep, voffB); PG8_STAGE(PG8_SA(0, 1), cA + hstep, voffA);
        if (wr == 1) PG8_BAR;
        PG8_WAIT_V(4); PG8_BAR;
        PG8_STAGE(PG8_SB(1, 0), cB + kstep, voffB); PG8_STAGE(PG8_SA(1, 0), cA + kstep, voffA); PG8_STAGE(PG8_SB(1, 1), cB + hstep + kstep, voffB);
        PG8_WAIT_V(6); PG8_BAR;
    }
    for (;;) {
        const bool has_next = S.next(ui + 1, nxt);
        const char* nA = has_next ? (const char*)g.A + (size_t)nxt.pm * tstep : cA; const char* nB = has_next ? (const char*)g.Bt + (size_t)nxt.pn * tstep : cB;
        for (int t = 0; t < nt; t += 2) {
            const bool last = (t == nt - 2);
            const char* a1 = cA + (size_t)(t + 1) * kstep;
            const char* a2 = last ? nA : cA + (size_t)(t + 2) * kstep; const char* b2 = last ? nB : cB + (size_t)(t + 2) * kstep;
            const char* a3 = a2 + kstep; const char* b3 = b2 + kstep;
            if (last && has_next) S.a_ready(nxt);
            if constexpr (SP2) {
            PG8_LDB(B0, 0, 0); PG8_LDB(B1, 0, 1); PG8_SCHED; PG8_LDA(At, 0, 0); PG8_STAGE(PG8_SA(1, 1), a1 + hstep, voffA);
            PG8_WAIT_V(8); PG8_WAIT_L(0); PG8_BAR; PG8_MMA(0, 0, At, B0); PG8_MMA(0, 1, At, B1); PG8_BAR; PG8_SCHED;
            PG8_LDA(At, 0, 1); PG8_STAGE(PG8_SB(0, 0), b2, voffB); PG8_STAGE(PG8_SB(0, 1), b2 + hstep, voffB); PG8_STAGE(PG8_SA(0, 0), a2, voffA);
            PG8_WAIT_V(8); PG8_WAIT_L(0); PG8_BAR; PG8_MMA(1, 0, At, B0); PG8_MMA(1, 1, At, B1); PG8_BAR; PG8_SCHED;
            PG8_LDB(B0, 1, 0); PG8_LDB(B1, 1, 1); PG8_SCHED; PG8_LDA(At, 1, 0); PG8_STAGE(PG8_SA(0, 1), a2 + hstep, voffA);
            PG8_WAIT_V(8); PG8_WAIT_L(0); PG8_BAR; PG8_MMA(0, 0, At, B0); PG8_MMA(0, 1, At, B1); PG8_BAR; PG8_SCHED;
            PG8_LDA(At, 1, 1); PG8_STAGE(PG8_SB(1, 0), b3, voffB); PG8_STAGE(PG8_SB(1, 1), b3 + hstep, voffB); PG8_STAGE(PG8_SA(1, 0), a3, voffA);
            PG8_WAIT_V(8); PG8_WAIT_L(0); PG8_BAR; PG8_MMA(1, 0, At, B0); PG8_MMA(1, 1, At, B1); PG8_BAR; PG8_SCHED;
            } else {
            PG8_LDB(B0, 0, 0); PG8_SCHED; PG8_LDA(At, 0, 0); PG8_STAGE(PG8_SA(1, 1), a1 + hstep, voffA);
            PG8_WAIT_L(8); PG8_BAR; PG8_WAIT_L(0); PG8_MMA(0, 0, At, B0); PG8_BAR; PG8_SCHED;
            PG8_LDB(B1, 0, 1); PG8_STAGE(PG8_SB(0, 0), b2, voffB);
            PG8_BAR; PG8_WAIT_L(0); PG8_MMA(0, 1, At, B1); PG8_BAR;
            PG8_LDA(At, 0, 1); PG8_STAGE(PG8_SA(0, 0), a2, voffA);
            PG8_BAR; PG8_WAIT_L(0); PG8_MMA(1, 0, At, B0); PG8_BAR; PG8_SCHED;
            PG8_STAGE(PG8_SB(0, 1), b2 + hstep, voffB);
            PG8_WAIT_V(6); PG8_BAR; PG8_MMA(1, 1, At, B1); PG8_BAR;
            PG8_LDB(B0, 1, 0); PG8_SCHED; PG8_LDA(At, 1, 0); PG8_STAGE(PG8_SA(0, 1), a2 + hstep, voffA);
            PG8_WAIT_L(8); PG8_BAR; PG8_WAIT_L(0); PG8_MMA(0, 0, At, B0); PG8_BAR; PG8_SCHED;
            PG8_LDB(B1, 1, 1); PG8_STAGE(PG8_SB(1, 0), b3, voffB);
            PG8_BAR; PG8_WAIT_L(0); PG8_MMA(0, 1, At, B1); PG8_BAR;
            PG8_LDA(At, 1, 1); PG8_STAGE(PG8_SA(1, 0), a3, voffA);
            PG8_BAR; PG8_WAIT_L(0); PG8_MMA(1, 0, At, B0); PG8_BAR; PG8_SCHED;
            PG8_STAGE(PG8_SB(1, 1), b3 + hstep, voffB);
            PG8_WAIT_V(6); PG8_BAR; PG8_MMA(1, 1, At, B1); PG8_BAR;
            }
        }
        if constexpr (ALIGN_EPI) { if (wr == 0) PG8_BAR; }
        if constexpr (!Epi::AFTER_DRAIN) { E(acc, cur, wr, wc, fr, fq); S.done(cur); }
        if (!has_next) break;
#pragma unroll
        for (int a = 0; a < 2; ++a)
#pragma unroll
            for (int b = 0; b < 2; ++b)
#pragma unroll
                for (int m = 0; m < 4; ++m)
#pragma unroll
                    for (int n = 0; n < 2; ++n) acc[a][b][m][n] = (f32x4){0.f, 0.f, 0.f, 0.f};
        cur = nxt; cA = nA; cB = nB; ++ui;
        if constexpr (ALIGN_EPI) { if (wr == 1) PG8_BAR; }
    }
    PG8_WAIT_V(0);
    if constexpr (!ALIGN_EPI) { if (wr == 0) PG8_BAR; }
    PG8_BAR;
    if constexpr (Epi::AFTER_DRAIN) { E.fused(acc, cur, wr, wc, fr, fq, lds, wid, lane); S.done(cur); }
#undef PG8_SA
#undef PG8_SB
#undef PG8_STAGE
#undef PG8_LDA
#undef PG8_LDB
#undef PG8_MMA
#undef PG8_WAIT_V
#undef PG8_WAIT_L
#undef PG8_BAR
#undef PG8_SCHED
}
}
namespace attn_body {
using bf16=__hip_bfloat16;
using bf16x8=__attribute__((ext_vector_type(8)))short;
using s16x4=__attribute__((ext_vector_type(4)))short;
using f32x16=__attribute__((ext_vector_type(16)))float;
using u32x4=__attribute__((ext_vector_type(4)))unsigned;
constexpr int SEQ=2048,D=64,QKVP=3072,OUTP=1024;
constexpr int NW=8,QBLK=32,QB=QBLK*NW,KVBLK=64,NQB=SEQ/QB;

__device__ __forceinline__ int crow(int r,int hi){return (r&3)+8*(r>>2)+4*hi;}
#define SBAR() __builtin_amdgcn_sched_barrier(0)
__device__ __forceinline__ void cmask(f32x16&p0,f32x16&p1,int jb,int qrel,int hi){
  const float NEG=-INFINITY; int kb=64*jb+4*hi;
  #pragma unroll
  for(int r=0;r<16;++r){int kv=kb+(r&3)+8*(r>>2); if(kv>qrel)p0[r]=NEG; if(kv+32>qrel)p1[r]=NEG;}
}

constexpr int NSLOT=3, SLOTB=8192;
constexpr int LDS_K=0, LDS_V=NSLOT*SLOTB, LDS_WS=2*NSLOT*SLOTB, LDS_OST=LDS_WS+NW*64*4, LDS_BYTES=LDS_OST+NW*4096;
constexpr float C2=0.125f*1.4426950408889634f;
__device__ __forceinline__ void glds16(const void*gsrc,unsigned lds_dst){unsigned keep;
  asm volatile("s_mov_b32 %0, m0\n\ts_mov_b32 m0, %2\n\ts_nop 0\n\tglobal_load_lds_dwordx4 %1, off\n\ts_mov_b32 m0, %0":"=&s"(keep):"v"(gsrc),"s"(lds_dst):"memory");}
__device__ __forceinline__ float max3f(float a,float b,float c){float r;asm("v_max3_f32 %0, %1, %2, %3":"=v"(r):"v"(a),"v"(b),"v"(c));return r;}
__device__ __forceinline__ float max2f(float a,float b){float r;asm("v_max_f32_e32 %0, %1, %2":"=v"(r):"v"(a),"v"(b));return r;}
__device__ __forceinline__ float fadd_s(float a,float b){float r;asm("v_add_f32_e32 %0, %1, %2":"=v"(r):"v"(a),"v"(b));return r;}
__device__ __forceinline__ float fsub_s(float a,float b){float r;asm("v_sub_f32_e32 %0, %1, %2":"=v"(r):"v"(a),"v"(b));return r;}
typedef float f32x2_t __attribute__((ext_vector_type(2))); typedef __bf16 bf16x2_t __attribute__((ext_vector_type(2)));
__device__ __forceinline__ unsigned cvtpk_s(float lo,float hi){f32x2_t v={lo,hi};bf16x2_t b=__builtin_convertvector(v,bf16x2_t);return __builtin_bit_cast(unsigned,b);}
#define WAIT_BAR(N) asm volatile("s_waitcnt vmcnt(" #N ") lgkmcnt(0)\n\ts_barrier":::"memory")

__device__ __forceinline__ void qkt(f32x16&p0,f32x16&p1,const char*Kslot,const bf16x8*qr,const f32x16&negm,int r32,int hi){
  const char*kb=Kslot+hi*1024+r32*16;
  #pragma unroll
  for(int d0=0;d0<4;++d0){
    const bf16x8 b0=*reinterpret_cast<const bf16x8*>(kb+d0*2048);
    const bf16x8 b1=*reinterpret_cast<const bf16x8*>(kb+d0*2048+512);
    if(d0==0){p0=__builtin_amdgcn_mfma_f32_32x32x16_bf16(b0,qr[0],negm,0,0,0);p1=__builtin_amdgcn_mfma_f32_32x32x16_bf16(b1,qr[0],negm,0,0,0);}
    else{p0=__builtin_amdgcn_mfma_f32_32x32x16_bf16(b0,qr[d0],p0,0,0,0);p1=__builtin_amdgcn_mfma_f32_32x32x16_bf16(b1,qr[d0],p1,0,0,0);}}
}
typedef __attribute__((address_space(3))) const char* lds_cptr;
typedef short v4i16_t __attribute__((ext_vector_type(4)));
__device__ __forceinline__ void kload8(bf16x8*kf,lds_cptr kp){
  kf[0]=*(const __attribute__((address_space(3))) bf16x8*)(kp);      kf[1]=*(const __attribute__((address_space(3))) bf16x8*)(kp+512);
  kf[2]=*(const __attribute__((address_space(3))) bf16x8*)(kp+2048); kf[3]=*(const __attribute__((address_space(3))) bf16x8*)(kp+2560);
  kf[4]=*(const __attribute__((address_space(3))) bf16x8*)(kp+4096); kf[5]=*(const __attribute__((address_space(3))) bf16x8*)(kp+4608);
  kf[6]=*(const __attribute__((address_space(3))) bf16x8*)(kp+6144); kf[7]=*(const __attribute__((address_space(3))) bf16x8*)(kp+6656);
}
__device__ __forceinline__ void kload2(bf16x8*kf,lds_cptr kp,int j){ kf[2*j]=*(const __attribute__((address_space(3))) bf16x8*)(kp+j*2048); kf[2*j+1]=*(const __attribute__((address_space(3))) bf16x8*)(kp+j*2048+512); }
__device__ __forceinline__ s16x4 vtr(lds_cptr p){ return __builtin_bit_cast(s16x4,__builtin_amdgcn_ds_read_tr16_b64_v4i16((__attribute__((address_space(3))) v4i16_t*)p)); }
__device__ __forceinline__ float rowmax(const f32x16&p0,const f32x16&p1){
  float a=max3f(p0[0],p0[1],p1[0]),b=max3f(p0[2],p0[3],p1[1]);a=max3f(a,p1[2],p1[3]);
  #pragma unroll
  for(int r=4;r<16;r+=4){a=max3f(a,p0[r],p0[r+1]);b=max3f(b,p0[r+2],p0[r+3]);a=max3f(a,p1[r],p1[r+1]);b=max3f(b,p1[r+2],p1[r+3]);}
  const float m=max2f(a,b);
  auto rr=__builtin_amdgcn_permlane32_swap(__float_as_uint(m),__float_as_uint(m),false,false);
  return max2f(__uint_as_float(rr[0]),__uint_as_float(rr[1]));
}
__device__ __forceinline__ void pv(f32x16*o,int vb,bf16x8 pa0,bf16x8 pa1,bf16x8 pa2,bf16x8 pa3){
  #pragma unroll
  for(int d0=0;d0<2;++d0){s16x4 lo[4],hi[4];
    #pragma unroll
    for(int ks=0;ks<4;++ks){
      asm volatile("ds_read_b64_tr_b16 %0,%1 offset:%c2":"=&v"(lo[ks]):"v"(vb),"i"(d0*4096+ks*1024):"memory");
      asm volatile("ds_read_b64_tr_b16 %0,%1 offset:%c2":"=&v"(hi[ks]):"v"(vb),"i"(d0*4096+ks*1024+512):"memory");}
    asm volatile("s_waitcnt lgkmcnt(0)":::"memory");SBAR();
    #define PK(k) (bf16x8){lo[k][0],lo[k][1],lo[k][2],lo[k][3],hi[k][0],hi[k][1],hi[k][2],hi[k][3]}
    o[d0]=__builtin_amdgcn_mfma_f32_32x32x16_bf16(pa0,PK(0),o[d0],0,0,0);
    o[d0]=__builtin_amdgcn_mfma_f32_32x32x16_bf16(pa1,PK(1),o[d0],0,0,0);
    o[d0]=__builtin_amdgcn_mfma_f32_32x32x16_bf16(pa2,PK(2),o[d0],0,0,0);
    o[d0]=__builtin_amdgcn_mfma_f32_32x32x16_bf16(pa3,PK(3),o[d0],0,0,0);
    #undef PK
  }
}

__device__ __forceinline__ void pv_rm(f32x16*o,int vbA,int vbB,bf16x8 pa0,bf16x8 pa1,bf16x8 pa2,bf16x8 pa3){
  #pragma unroll
  for(int d0=0;d0<2;++d0){s16x4 lo[4],hi[4]; const int vb=d0?vbB:vbA;
    #pragma unroll
    for(int ks=0;ks<4;++ks){
      asm volatile("ds_read_b64_tr_b16 %0,%1 offset:%c2":"=&v"(lo[ks]):"v"(vb),"i"(ks*2048):"memory");
      asm volatile("ds_read_b64_tr_b16 %0,%1 offset:%c2":"=&v"(hi[ks]):"v"(vb),"i"(ks*2048+1024):"memory");}
    asm volatile("s_waitcnt lgkmcnt(0)":::"memory");SBAR();
    #define PK(k) (bf16x8){lo[k][0],lo[k][1],lo[k][2],lo[k][3],hi[k][0],hi[k][1],hi[k][2],hi[k][3]}
    o[d0]=__builtin_amdgcn_mfma_f32_32x32x16_bf16(pa0,PK(0),o[d0],0,0,0);
    o[d0]=__builtin_amdgcn_mfma_f32_32x32x16_bf16(pa1,PK(1),o[d0],0,0,0);
    o[d0]=__builtin_amdgcn_mfma_f32_32x32x16_bf16(pa2,PK(2),o[d0],0,0,0);
    o[d0]=__builtin_amdgcn_mfma_f32_32x32x16_bf16(pa3,PK(3),o[d0],0,0,0);
    #undef PK
  }
}

#ifndef ATTN_STORE16
#define ATTN_STORE16(p,v) (*(u32x4*)(p)=(v))
#endif
template<int THRL> __device__ __forceinline__ void attn_unit(int b,int qb,const bf16*Q,const bf16*__restrict__ K,const bf16*__restrict__ V,bf16*O,char*shm,bool pref_in,bool has_next,long dK,long dV,bf16x8 (&qr)[4],int nqb,long dQ){
  const int tid=opaque_tid(),lane=tid&63,r32=lane&31,hi=lane>>5; const int wid=__builtin_amdgcn_readfirstlane(tid>>6);
  const long rowbase=(long)b*SEQ; const int q0=qb*QB;
  const bf16*Qw=Q+(rowbase+q0+wid*QBLK)*QKVP;
  const bf16*Kh=K,*Vh=V;
  const unsigned lds0=(unsigned)(uintptr_t)shm;
  float*wsf=(float*)(shm+LDS_WS)+wid*64;
  const bf16*ksrc=Kh+wid*512+lane*8;
  const bf16*vsrc=Vh+wid*512+lane*8;
  const unsigned kdst=lds0+LDS_K+wid*1024, vdst=lds0+LDS_V+wid*1024;
  #define DMA_K(t,slot) glds16(ksrc+(long)(t)*4096,(unsigned)__builtin_amdgcn_readfirstlane(kdst+(slot)))
  #define DMA_V(t,slot) glds16(vsrc+(long)(t)*4096,(unsigned)__builtin_amdgcn_readfirstlane(vdst+(slot)))
  const int vb0=(int)(lds0+LDS_V)+((lane>>4)&1)*32+(lane&3)*8+(4*hi+((lane&15)>>2))*64;
  const char*Kbase=shm+LDS_K; bf16x8 kf[8];
  const lds_cptr shm3=(lds_cptr)shm; const lds_cptr kp0=shm3+LDS_K+hi*1024+r32*16; const lds_cptr vp0=shm3+LDS_V+((lane>>4)&1)*32+(lane&3)*8+(4*hi+((lane&15)>>2))*64;
  const int NT=(q0+QB)/KVBLK;
  if(!pref_in){DMA_K(0,0);DMA_V(0,0);DMA_K(1,SLOTB);}
  if(!pref_in){
  #pragma unroll
  for(int d0=0;d0<4;++d0)qr[d0]=*reinterpret_cast<const bf16x8*>(&Qw[(long)r32*QKVP+d0*16+hi*8]); }
  float mhat=0.f,l_reg=0.f;f32x16 o[2];o[0]=f32x16{};o[1]=f32x16{};f32x16 negm=f32x16{};asm volatile("":"+v"(negm));
  const int qrel=wid*QBLK+r32;
  #define CMASK(P0,P1,t) do{int jb_=(t)-(NT-4); if(jb_>=0)cmask(P0,P1,jb_,qrel,hi);}while(0)
  bool resc=false;
  #define START(P0,P1) do{ const float rm=rowmax(P0,P1); resc=false; \
    { const float dl=rm; mhat=fadd_s(mhat,dl); \
      _Pragma("unroll") for(int r=0;r<16;++r){P0[r]=fsub_s(P0[r],dl);P1[r]=fsub_s(P1[r],dl);} \
      _Pragma("unroll") for(int r=0;r<16;++r)negm[r]=-mhat; asm volatile("":"+v"(negm)); } \
    _Pragma("unroll") for(int r=0;r<16;++r)P0[r]=__builtin_amdgcn_exp2f(P0[r]); }while(0)
  #define RESC() do{ if(resc){ asm volatile("s_waitcnt lgkmcnt(0)":::"memory"); \
      _Pragma("unroll") for(int d_=0;d_<2;++d_) _Pragma("unroll") for(int r=0;r<16;++r)o[d_][r]*=wsf[crow(r,hi)]; } }while(0)
  f32x16 pA0,pA1,pB0,pB1;
  int sl_prev=0,sl_cur=0,sl_next=SLOTB;
  #define ROT() do{sl_prev=sl_cur;sl_cur=sl_next;sl_next=(sl_next==(NSLOT-1)*SLOTB)?0:sl_next+SLOTB;}while(0)
  DMA_K(2,2*SLOTB);
  WAIT_BAR(3);
  qkt(pA0,pA1,Kbase,qr,negm,r32,hi);asm volatile("s_nop 15\n\ts_nop 7":"+v"(pA0),"+v"(pA1));CMASK(pA0,pA1,0);
  START(pA0,pA1);
  _Pragma("unroll") for(int r=0;r<16;++r)pA1[r]=__builtin_amdgcn_exp2f(pA1[r]);
  WAIT_BAR(0);
  DMA_K(3,0);DMA_V(1,SLOTB);
  ROT();
  kload8(kf,kp0+sl_cur);
  WAIT_BAR(2);
  s16x4 vlo[8],vhi[8]; u32x4 pw0,pw1,pw2,pw3;
  #define PKW(P,B) cvtpk_s(P[B],P[B+1])
  #define PAF(k) __builtin_bit_cast(bf16x8,pw##k)
  #define VFR(i) (bf16x8){vlo[i][0],vlo[i][1],vlo[i][2],vlo[i][3],vhi[i][0],vhi[i][1],vhi[i][2],vhi[i][3]}
  #define PIN(x) asm volatile("":"+v"(x))
  #define MX3(a,b,c) __builtin_fmaxf(__builtin_fmaxf((a),(b)),(c))
  #define GAPA(MF,A0,A1,A2,A3,W0,W1,PW) do{ MF; sacc+=A0; sacc+=A1; sacc+=A2; sacc+=A3; PIN(sacc); W0; W1; PIN(PW); SBAR(); }while(0)
  #define EX(v) __builtin_amdgcn_exp2f(v)
  #define GAPB(MF,X,B) do{ MF; X[B]=EX(X[B]); X[B+1]=EX(X[B+1]); X[B+2]=EX(X[B+2]); X[B+3]=EX(X[B+3]); PIN(X); SBAR(); }while(0)
  #define VRD(i) do{ vlo[i]=vtr(vp_+(((i)>>2)*4096+((i)&3)*1024)); vhi[i]=vtr(vp_+(((i)>>2)*4096+((i)&3)*1024+512)); }while(0)
  #define KRD(G,j) do{ if(G){ kload2(kf,kp0+sl_next,j); SBAR(); } }while(0)
  #define STEP(C0,C1,P0,P1,t,GK,GV,GL) do{ SBAR(); \
    const lds_cptr vp_=vp0+sl_prev; \
    VRD(0); SBAR(); float sacc=(P0[0]+P0[1]); \
    GAPA(C0=__builtin_amdgcn_mfma_f32_32x32x16_bf16(kf[0],qr[0],negm,0,0,0), P0[2],P0[3],P0[4],P0[5],     pw0[0]=PKW(P0,0), pw0[1]=PKW(P0,2), pw0); \
    VRD(4); SBAR(); GAPA(C1=__builtin_amdgcn_mfma_f32_32x32x16_bf16(kf[1],qr[0],negm,0,0,0), P0[6],P0[7],P0[8],P0[9],     pw0[2]=PKW(P0,4), pw0[3]=PKW(P0,6), pw0); \
    VRD(1); SBAR(); GAPA(C0=__builtin_amdgcn_mfma_f32_32x32x16_bf16(kf[2],qr[1],C0,0,0,0),   P0[10],P0[11],P0[12],P0[13], pw1[0]=PKW(P0,8), pw1[1]=PKW(P0,10), pw1); \
    VRD(5); SBAR(); GAPA(C1=__builtin_amdgcn_mfma_f32_32x32x16_bf16(kf[3],qr[1],C1,0,0,0),   P0[14],P0[15],P1[0],P1[1],   pw1[2]=PKW(P0,12),pw1[3]=PKW(P0,14), pw1); \
    VRD(2); SBAR(); GAPA(C0=__builtin_amdgcn_mfma_f32_32x32x16_bf16(kf[4],qr[2],C0,0,0,0),   P1[2],P1[3],P1[4],P1[5],     pw2[0]=PKW(P1,0), pw2[1]=PKW(P1,2), pw2); \
    VRD(6); SBAR(); GAPA(C1=__builtin_amdgcn_mfma_f32_32x32x16_bf16(kf[5],qr[2],C1,0,0,0),   P1[6],P1[7],P1[8],P1[9],     pw2[2]=PKW(P1,4), pw2[3]=PKW(P1,6), pw2); \
    VRD(3); SBAR(); GAPA(C0=__builtin_amdgcn_mfma_f32_32x32x16_bf16(kf[6],qr[3],C0,0,0,0),   P1[10],P1[11],P1[12],P1[13], pw3[0]=PKW(P1,8), pw3[1]=PKW(P1,10), pw3); \
    VRD(7); SBAR(); GAPA(C1=__builtin_amdgcn_mfma_f32_32x32x16_bf16(kf[7],qr[3],C1,0,0,0),   P1[14],P1[15],0.f,0.f,       pw3[2]=PKW(P1,12),pw3[3]=PKW(P1,14), pw3); \
    l_reg+=sacc; \
    if(GK){DMA_K((t)+3,sl_cur);} if(GV){DMA_V((t)+1,sl_next);} \
    CMASK(C0,C1,t); \
    { float a=MX3(C0[0],C0[1],C1[0]),b=MX3(C0[2],C0[3],C1[1]); a=MX3(a,C1[2],C1[3]); \
      _Pragma("unroll") for(int r=4;r<16;r+=4){a=MX3(a,C0[r],C0[r+1]);b=MX3(b,C0[r+2],C0[r+3]);a=MX3(a,C1[r],C1[r+1]);b=MX3(b,C1[r+2],C1[r+3]);} \
      float rm=__builtin_fmaxf(a,b); { auto rr=__builtin_amdgcn_permlane32_swap(__float_as_uint(rm),__float_as_uint(rm),false,false); rm=__builtin_fmaxf(__uint_as_float(rr[0]),__uint_as_float(rr[1])); } \
      resc=false; \
      if(__builtin_expect(__any(rm>(float)THRL),0)){ const float dl=__builtin_fmaxf(rm,0.f); mhat+=dl; \
        _Pragma("unroll") for(int r=0;r<16;++r){C0[r]-=dl;C1[r]-=dl;} \
        _Pragma("unroll") for(int r=0;r<16;++r)negm[r]=-mhat; asm volatile("":"+v"(negm)); \
        const float f=__builtin_amdgcn_exp2f(-dl); l_reg*=f; if(hi==0)wsf[r32]=f; resc=true; } } \
    SBAR(); \
    GAPB(o[0]=__builtin_amdgcn_mfma_f32_32x32x16_bf16(PAF(0),VFR(0),o[0],0,0,0), C0,0); \
    GAPB(o[1]=__builtin_amdgcn_mfma_f32_32x32x16_bf16(PAF(0),VFR(4),o[1],0,0,0), C0,4); \
    KRD(GL,0); GAPB(o[0]=__builtin_amdgcn_mfma_f32_32x32x16_bf16(PAF(1),VFR(1),o[0],0,0,0), C0,8); \
    KRD(GL,1); GAPB(o[1]=__builtin_amdgcn_mfma_f32_32x32x16_bf16(PAF(1),VFR(5),o[1],0,0,0), C0,12); \
    KRD(GL,2); GAPB(o[0]=__builtin_amdgcn_mfma_f32_32x32x16_bf16(PAF(2),VFR(2),o[0],0,0,0), C1,0); \
    KRD(GL,3); GAPB(o[1]=__builtin_amdgcn_mfma_f32_32x32x16_bf16(PAF(2),VFR(6),o[1],0,0,0), C1,4); \
    GAPB(o[0]=__builtin_amdgcn_mfma_f32_32x32x16_bf16(PAF(3),VFR(3),o[0],0,0,0), C1,8); \
    GAPB(o[1]=__builtin_amdgcn_mfma_f32_32x32x16_bf16(PAF(3),VFR(7),o[1],0,0,0), C1,12); \
    }while(0)
  int t=1;
  #undef CMASK
  #define CMASK(P0,P1,t) do{}while(0)
  for(;t+5<NT;t+=2){
    STEP(pB0,pB1,pA0,pA1,t,true,true,true);     WAIT_BAR(2); RESC(); ROT();
    STEP(pA0,pA1,pB0,pB1,t+1,true,true,true);   WAIT_BAR(2); RESC(); ROT();
  }
  #undef CMASK
  #define CMASK(P0,P1,t) do{int jb_=(t)-(NT-4); if(jb_>=0)cmask(P0,P1,jb_,qrel,hi);}while(0)
  #define ENDW(tt) do{ if((tt)+3<NT){WAIT_BAR(2);} else if((tt)+2<NT){WAIT_BAR(1);} else {WAIT_BAR(0);} }while(0)
  for(;t+1<NT;t+=2){
    STEP(pB0,pB1,pA0,pA1,t,(t+3<NT),(t+1<NT),(t+1<NT));       ENDW(t);   RESC(); ROT();
    STEP(pA0,pA1,pB0,pB1,t+1,(t+4<NT),(t+2<NT),(t+2<NT));     ENDW(t+1); RESC(); ROT();
  }
  STEP(pB0,pB1,pA0,pA1,NT-1,false,false,false); RESC();
  { float sacc=pB0[0]+pB0[1]; _Pragma("unroll") for(int r=2;r<16;++r)sacc+=pB0[r]; _Pragma("unroll") for(int r=0;r<16;++r)sacc+=pB1[r]; l_reg+=sacc;
    pw0=(u32x4){PKW(pB0,0),PKW(pB0,2),PKW(pB0,4),PKW(pB0,6)};pw1=(u32x4){PKW(pB0,8),PKW(pB0,10),PKW(pB0,12),PKW(pB0,14)};pw2=(u32x4){PKW(pB1,0),PKW(pB1,2),PKW(pB1,4),PKW(pB1,6)};pw3=(u32x4){PKW(pB1,8),PKW(pB1,10),PKW(pB1,12),PKW(pB1,14)};
    SBAR(); pv(o,vb0+sl_cur,PAF(0),PAF(1),PAF(2),PAF(3)); }
  if(has_next){ asm volatile("s_waitcnt lgkmcnt(0)\n\ts_barrier":::"memory");
    glds16(ksrc+dK,(unsigned)__builtin_amdgcn_readfirstlane(kdst)); glds16(vsrc+dV,(unsigned)__builtin_amdgcn_readfirstlane(vdst)); glds16(ksrc+dK+4096L,(unsigned)__builtin_amdgcn_readfirstlane(kdst+SLOTB));
    const bf16*nQw=Q+dQ+(rowbase+(long)nqb*QB+wid*QBLK)*QKVP;
    #pragma unroll
    for(int d0=0;d0<4;++d0)qr[d0]=*reinterpret_cast<const bf16x8*>(&nQw[(long)r32*QKVP+d0*16+hi*8]); }
  #undef PKW
  #undef PAF
  #undef VFR
  #undef PIN
  #undef MX3
  #undef GAPA
  #undef GAPB
  #undef EX
  #undef VRD
  #undef KRD
  #undef STEP
  #undef ENDW
  {auto rr=__builtin_amdgcn_permlane32_swap(__float_as_uint(l_reg),__float_as_uint(l_reg),false,false);l_reg=__uint_as_float(rr[0])+__uint_as_float(rr[1]);}
  if(hi==0)wsf[32+r32]=l_reg;asm volatile("s_waitcnt lgkmcnt(0)":::"memory");
  float rli[16];
  #pragma unroll
  for(int r=0;r<16;++r)rli[r]=__builtin_amdgcn_rcpf(wsf[32+crow(r,hi)]);
  bf16*Ow=O+(rowbase+q0+wid*QBLK)*OUTP;
  { bf16*stg=(bf16*)(shm+LDS_OST)+wid*2048;
    #pragma unroll
    for(int r=0;r<16;++r){const int orow=crow(r,hi);
      #pragma unroll
      for(int d0=0;d0<2;++d0)stg[orow*64+d0*32+r32]=__float2bfloat16(o[d0][r]*rli[r]);}
    asm volatile("s_waitcnt lgkmcnt(0)":::"memory");
    #pragma unroll
    for(int i=0;i<4;++i){const int row=i*8+(lane>>3),ch=lane&7; const u32x4 v=*(const u32x4*)(stg+row*64+ch*8); ATTN_STORE16(Ow+(long)row*OUTP+ch*8,v);} }
  asm volatile("s_waitcnt lgkmcnt(0)\n\ts_barrier":::"memory");
  #undef DMA_K
  #undef DMA_V
  #undef CMASK
  #undef START
  #undef RESC
  #undef ROT
}
typedef float f32x2_v __attribute__((ext_vector_type(2)));
__device__ __forceinline__ void qkt_rm(f32x16&p0,f32x16&p1,const char*Kslot,const bf16x8*qr,const f32x16&negm,int r32,int hi){
  const char*kb=Kslot+r32*128; const int sw=r32&7;
  #pragma unroll
  for(int d0=0;d0<4;++d0){
    const int off=((2*d0+hi)^sw)*16;
    const bf16x8 b0=*reinterpret_cast<const bf16x8*>(kb+off);
    const bf16x8 b1=*reinterpret_cast<const bf16x8*>(kb+4096+off);
    if(d0==0){p0=__builtin_amdgcn_mfma_f32_32x32x16_bf16(b0,qr[0],negm,0,0,0);p1=__builtin_amdgcn_mfma_f32_32x32x16_bf16(b1,qr[0],negm,0,0,0);}
    else{p0=__builtin_amdgcn_mfma_f32_32x32x16_bf16(b0,qr[d0],p0,0,0,0);p1=__builtin_amdgcn_mfma_f32_32x32x16_bf16(b1,qr[d0],p1,0,0,0);}}
}
__device__ __forceinline__ void sb_block(const char*wl,const bf16x8*qr,bool diag,int qrel,int r32,int hi,float carry,float&ncarry,u32x4&pw0,u32x4&pw1,u32x4&pw2,u32x4&pw3){
    f32x16 p0,p1; const f32x16 zero=f32x16{};
    qkt_rm(p0,p1,wl,qr,zero,r32,hi);
    if(diag){ const int kb=4*hi;
      #pragma unroll
      for(int r=0;r<16;++r){const int kv=kb+(r&3)+8*(r>>2); if(kv>=qrel)p0[r]=-INFINITY; if(kv+32>=qrel)p1[r]=-INFINITY;} }
    f32x2_v R[16];
    #pragma unroll
    for(int r=0;r<16;++r){ f32x2_v z={p0[r],p1[r]}; z=__builtin_elementwise_min(z,(f32x2_v){126.f,126.f});
      f32x2_v e; e.x=__builtin_amdgcn_exp2f(z.x); e.y=__builtin_amdgcn_exp2f(z.y);
      const f32x2_v d=e+1.0f; f32x2_v rc; rc.x=__builtin_amdgcn_rcpf(d.x); rc.y=__builtin_amdgcn_rcpf(d.y);
      R[r]=rc; }
    f32x2_v Gp[4];
    #pragma unroll
    for(int i=0;i<4;++i)Gp[i]=(R[4*i]*R[4*i+1])*(R[4*i+2]*R[4*i+3]);
    float inc[9]; inc[8]=1.0f;
    #pragma unroll
    for(int i=7;i>=0;--i){ const float gp=(i<4)?Gp[i].x:Gp[i-4].y; inc[i]=gp*inc[i+1]; }
    float lo[9],up[8]; lo[8]=1.0f;
    #pragma unroll
    for(int i=0;i<8;++i){ auto rr=__builtin_amdgcn_permlane32_swap(__float_as_uint(inc[i]),__float_as_uint(inc[i]),false,false); lo[i]=__uint_as_float(rr[0]); up[i]=__uint_as_float(rr[1]); }
    ncarry=carry*(lo[0]*up[0]);
    unsigned wx[8],wy[8];
    #pragma unroll
    for(int i=0;i<4;++i){
      f32x2_v l3; l3.x=carry*inc[i+1]*(hi?lo[i+1]:up[i]); l3.y=carry*inc[i+5]*(hi?lo[i+5]:up[i+4]);
      const f32x2_v l2=l3*R[4*i+3], l1=l2*R[4*i+2], l0=l1*R[4*i+1];
      const f32x2_v w0=(1.0f-R[4*i])*l0, w1=(1.0f-R[4*i+1])*l1, w2=(1.0f-R[4*i+2])*l2, w3=(1.0f-R[4*i+3])*l3;
      wx[2*i]=cvtpk_s(w0.x,w1.x); wx[2*i+1]=cvtpk_s(w2.x,w3.x); wy[2*i]=cvtpk_s(w0.y,w1.y); wy[2*i+1]=cvtpk_s(w2.y,w3.y); }
    pw0=(u32x4){wx[0],wx[1],wx[2],wx[3]}; pw1=(u32x4){wx[4],wx[5],wx[6],wx[7]}; pw2=(u32x4){wy[0],wy[1],wy[2],wy[3]}; pw3=(u32x4){wy[4],wy[5],wy[6],wy[7]};
}
__device__ __forceinline__ void sb_item(int b,int gp,const bf16*Q,const bf16*__restrict__ K,const bf16*__restrict__ V,bf16*O,const float*__restrict__ gn,char*wl){
  const int tid=opaque_tid(),lane=tid&63,r32=lane&31,hi=lane>>5;
  const long rowbase=(long)b*SEQ; const int q0=gp*2*QBLK;
  const bf16*Qw=Q+(rowbase+q0)*QKVP;
  const bf16*Kh=K+rowbase*QKVP,*Vh=V+rowbase*QKVP;
  const unsigned lds0=(unsigned)__builtin_amdgcn_readfirstlane((unsigned)(uintptr_t)wl);
  const bf16*ksrc=Kh+(long)(lane>>3)*QKVP+(((lane&7)^(lane>>3))*8);
  const bf16*vsrc=Vh+(long)(lane>>3)*QKVP+(((lane&7)^(lane>>3))*8);
  #define DMA_K(t) do{ _Pragma("unroll") for(int c_=0;c_<8;++c_) glds16(ksrc+((long)(t)*KVBLK+8*c_)*QKVP,lds0+c_*1024); }while(0)
  #define DMA_V(t) do{ _Pragma("unroll") for(int w_=0;w_<8;++w_) glds16(vsrc+((long)(t)*KVBLK+8*w_)*QKVP,lds0+8192+w_*1024); }while(0)
  const int rl=4*hi+((lane&15)>>2), c2=2*((lane>>4)&1)+((lane&3)>>1);
  const int vbA=(int)(lds0+8192)+rl*128+(((0+c2)^rl)*16)+(lane&1)*8, vbB=(int)(lds0+8192)+rl*128+(((4+c2)^rl)*16)+(lane&1)*8;
  const int td=gp;
  DMA_K(td);DMA_V(td);
  bf16x8 qa[4],qb_[4];
  #pragma unroll
  for(int d0=0;d0<4;++d0){qa[d0]=*reinterpret_cast<const bf16x8*>(&Qw[(long)r32*QKVP+d0*16+hi*8]); qb_[d0]=*reinterpret_cast<const bf16x8*>(&Qw[(long)(32+r32)*QKVP+d0*16+hi*8]);}
  asm volatile("s_waitcnt vmcnt(0)":::"memory"); asm volatile("":"+v"(qa[0]),"+v"(qa[1]),"+v"(qa[2]),"+v"(qa[3]),"+v"(qb_[0]),"+v"(qb_[1]),"+v"(qb_[2]),"+v"(qb_[3]));
  f32x16 oa[2],ob[2];oa[0]=f32x16{};oa[1]=f32x16{};ob[0]=f32x16{};ob[1]=f32x16{};
  float ca=1.0f,cb=1.0f;
  for(int t=td;;--t){
    asm volatile("s_waitcnt vmcnt(8)":::"memory");
    float na,nb; u32x4 a0,a1,a2,a3,b0,b1,b2,b3;
    sb_block(wl,qa,t==td,r32,r32,hi,ca,na,a0,a1,a2,a3);
    SBAR();
    sb_block(wl,qb_,t==td,32+r32,r32,hi,cb,nb,b0,b1,b2,b3);
    const bool done=(t==0)||__all(__builtin_fmaxf(na,nb)<7.5e-37f);
    asm volatile("s_waitcnt lgkmcnt(0)":::"memory");
    if(!done)DMA_K(t-1);
    if(done) asm volatile("s_waitcnt vmcnt(0)":::"memory"); else asm volatile("s_waitcnt vmcnt(8)":::"memory");
    SBAR();
    pv_rm(oa,vbA,vbB,__builtin_bit_cast(bf16x8,a0),__builtin_bit_cast(bf16x8,a1),__builtin_bit_cast(bf16x8,a2),__builtin_bit_cast(bf16x8,a3));
    pv_rm(ob,vbA,vbB,__builtin_bit_cast(bf16x8,b0),__builtin_bit_cast(bf16x8,b1),__builtin_bit_cast(bf16x8,b2),__builtin_bit_cast(bf16x8,b3));
    if(done)break;
    DMA_V(t-1);
    ca=na;cb=nb;
  }
  { float*stg=(float*)wl;
    #pragma unroll
    for(int r=0;r<16;++r){const int orow=crow(r,hi);
      #pragma unroll
      for(int d0=0;d0<2;++d0){stg[orow*64+d0*32+r32]=oa[d0][r]; stg[(32+orow)*64+d0*32+r32]=ob[d0][r];}}
    asm volatile("s_waitcnt lgkmcnt(0)":::"memory");
    bf16*Ow=O+(rowbase+q0)*OUTP;
    typedef float f32x4_t __attribute__((ext_vector_type(4)));
    const int ch=lane&7; const f32x4_t g0=*(const f32x4_t*)(gn+ch*8), g1=*(const f32x4_t*)(gn+ch*8+4);
    #pragma unroll
    for(int i=0;i<8;++i){const int row=i*8+(lane>>3);
      const f32x4_t a=*(const f32x4_t*)(stg+row*64+ch*8), c=*(const f32x4_t*)(stg+row*64+ch*8+4);
      float ss=((a[0]*a[0]+a[1]*a[1])+(a[2]*a[2]+a[3]*a[3]))+((c[0]*c[0]+c[1]*c[1])+(c[2]*c[2]+c[3]*c[3]));
      ss+=__shfl_xor(ss,1); ss+=__shfl_xor(ss,2); ss+=__shfl_xor(ss,4);
      const float rstd=1.0f/sqrtf(ss*(1.0f/64.0f)+1e-5f);
      const f32x4_t ya=a*rstd*g0, yc=c*rstd*g1;
      const u32x4 v=(u32x4){cvtpk_s(ya[0],ya[1]),cvtpk_s(ya[2],ya[3]),cvtpk_s(yc[0],yc[1]),cvtpk_s(yc[2],yc[3])};
      *(u32x4*)(Ow+(long)row*OUTP+ch*8)=v; }
    asm volatile("s_waitcnt lgkmcnt(0)":::"memory"); }
  #undef DMA_K
  #undef DMA_V
}
constexpr int ATTN_LDS_BYTES=LDS_BYTES>NW*16384?LDS_BYTES:NW*16384;
#undef SBAR
#undef WAIT_BAR
}
namespace cg = cooperative_groups;
constexpr int NWAVES = 8;
constexpr int BATCH = 32, SEQ = 2048, DMODEL = 1024, INCOLS = 3072, DFF = 2816;
constexpr int M = BATCH * SEQ;
constexpr float EPS = 1e-5f;
constexpr float LAMBDA_INIT = 0.2f;
constexpr size_t MiB = 1u << 20;
constexpr size_t WS_RS0 = 512 * 1024;
constexpr size_t WS_SSQ1 = 34 * MiB, WS_SSQ2 = 38 * MiB;
constexpr size_t WS_BAR = 1 * MiB;
constexpr size_t WS_CNT = 42 * MiB, WS_XBUF = 44 * MiB;
constexpr size_t WS_ROPE = 2 * MiB;
constexpr size_t WS_WIN = 8 * MiB, WS_WOUT = 14 * MiB, WS_WGU = 16 * MiB, WS_WD = 27 * MiB;
constexpr size_t WS_XB = 64 * MiB;
constexpr size_t WS_PROJ = 192 * MiB;
constexpr size_t WS_MIX = 576 * MiB;
constexpr size_t WS_X1B = 704 * MiB;
constexpr size_t WS_KT = 832 * MiB, WS_VT = 896 * MiB;
constexpr size_t WS_END = 960 * MiB;
constexpr int RING_BYTES = 131072, MISC_OFF = RING_BYTES + 256, LDS_BYTES = 147456;
static_assert(attn_body::ATTN_LDS_BYTES <= RING_BYTES, "attention scratch fits the stage-buffer region");

#define GAS __attribute__((address_space(1)))
#define LAS __attribute__((address_space(3)))
typedef unsigned short bf16;
typedef unsigned v4u __attribute__((ext_vector_type(4)));
typedef float f32x4 __attribute__((ext_vector_type(4)));
__device__ __forceinline__ unsigned f2bf(float f) { unsigned u = __builtin_bit_cast(unsigned, f); return (u + 0x7fffu + ((u >> 16) & 1u)) >> 16; }
__device__ __forceinline__ unsigned pk2(float lo, float hi) { return f2bf(lo) | (f2bf(hi) << 16); }
__device__ __forceinline__ float wave_sum(float v) {
#pragma unroll
    for (int o = 1; o < 64; o <<= 1) v += __shfl_xor(v, o);
    return v;
}
__device__ __forceinline__ void p0_transpose_item(const float* W, const float* gk, int K, int N, bf16* WT, int mode, LAS float* scr, int item, int lane) {
    const int nblk = N / 32, kb = item / nblk, nb = item % nblk, k0 = 64 * kb, n0 = 32 * nb;
#pragma unroll 8
    for (int i = 0; i < 32; ++i) { const int kk = 2 * i + (lane >> 5); float w = __builtin_nontemporal_load(&W[(size_t)(k0 + kk) * N + n0 + (lane & 31)]); if (gk) w *= gk[k0 + kk]; scr[kk * 33 + (lane & 31)] = w; }
    asm volatile("s_waitcnt lgkmcnt(0)" ::: "memory");
    const int c = lane & 7;
    const int drow0 = (mode == 0 || mode == 3) ? n0 : (n0 / 128) * 256 + (mode - 1) * 128 + (n0 % 128);
    const bool rperm = (mode == 3) && (n0 < 1024) && ((n0 & 63) == 0);
#pragma unroll
    for (int j = 0; j < 4; ++j) { const int n = (lane >> 3) + 8 * j; const LAS float* s = scr + (8 * c) * 33 + n;
        v4u o; o.x = pk2(s[0 * 33], s[1 * 33]); o.y = pk2(s[2 * 33], s[3 * 33]); o.z = pk2(s[4 * 33], s[5 * 33]); o.w = pk2(s[6 * 33], s[7 * 33]);
        const int nd = (rperm && n < 16) ? ((n < 8) ? 2 * n : 2 * (n - 8) + 1) : n;
        if (mode == 3) *(v4u*)(WT + (size_t)(drow0 + nd) * K + k0 + 8 * c) = o;
        else __builtin_nontemporal_store(o, (v4u*)(WT + (size_t)(drow0 + nd) * K + k0 + 8 * c)); }
    asm volatile("s_waitcnt lgkmcnt(0)" ::: "memory");
}

typedef GAS unsigned gu32;
#define RLX_AGENT __ATOMIC_RELAXED, __HIP_MEMORY_SCOPE_AGENT
#define XB_TMO      128
#define XB_XCNT(j)  (256  + 64 * (j))
#define XB_XSUB(j)  (1280 + 64 * (j))
#define XB_XGEN(j)  (2304 + 64 * (j))
#define XB_TOP      3328
#define XB_TOPGEN   3392
#define XCD_BAR_WORDS 3456
#define SBQ_WORD0 3584
#define CTL_WORDS (SBQ_WORD0 + 8 * 64)
#define XB_SPIN_CAP (1u << 18)

__device__ __forceinline__ unsigned xb_ld(unsigned* p)              { return __hip_atomic_load(p, __ATOMIC_RELAXED, __HIP_MEMORY_SCOPE_AGENT); }
__device__ __forceinline__ unsigned xb_add(unsigned* p, unsigned v) { return __hip_atomic_fetch_add(p, v, __ATOMIC_RELAXED, __HIP_MEMORY_SCOPE_AGENT); }
__device__ __forceinline__ unsigned xb_xcc_id() { return (unsigned)__builtin_amdgcn_s_getreg((3 << 11) | 20) & 0xFu; }
#define XB_SPIN(cond, bar) do { unsigned _sp = 0; while (cond) { __builtin_amdgcn_s_sleep(1); \
    if ((++_sp & 255u) == 0u) { if (xb_ld(&(bar)[XB_TMO])) break; if (_sp > XB_SPIN_CAP) { atomicAdd(&(bar)[XB_TMO], 1u); break; } } } } while (0)

struct XcdBarrier {
    unsigned* bar; unsigned x;
    volatile LAS unsigned* st;
};

__device__ __forceinline__ XcdBarrier xcd_barrier_post(unsigned* bar, volatile LAS unsigned* st) {
    XcdBarrier b; b.bar = bar; b.x = xb_xcc_id(); b.st = st;
    if (threadIdx.x == 0) (void)xb_add(&bar[XB_XCNT(b.x)], 1u);
    return b;
}
__device__ __forceinline__ void xcd_barrier_complete(unsigned* bar, unsigned x, unsigned& nloc, unsigned& nx) {
    const unsigned G = gridDim.x * gridDim.y * gridDim.z;
    unsigned sum, cnt, mine, sp = 0u;
    for (;;) {
        sum = 0u; cnt = 0u; mine = 0u;
#pragma unroll
        for (unsigned j = 0; j < 16; ++j) { const unsigned c = xb_ld(&bar[XB_XCNT(j)]); sum += c; cnt += (c > 0u) ? 1u : 0u; mine = (j == x) ? c : mine; }
        if (sum == G) break;
        __builtin_amdgcn_s_sleep(1);
        if ((++sp & 255u) == 0u) { if (xb_ld(&bar[XB_TMO])) break; if (sp > XB_SPIN_CAP) { atomicAdd(&bar[XB_TMO], 1u); break; } }
    }
    nloc = mine > 0u ? mine : 1u; nx = cnt > 0u ? cnt : 1u;
}

__device__ __forceinline__ void xcd_barrier(const XcdBarrier& b) {
    asm volatile("s_waitcnt vmcnt(0)" ::: "memory");
    __syncthreads();
    if (threadIdx.x == 0) {
        unsigned* bar = b.bar;
        __builtin_amdgcn_s_waitcnt(0);
        unsigned nloc = b.st[0], nx = b.st[1];
        if (nloc == 0u) { xcd_barrier_complete(bar, b.x, nloc, nx); b.st[0] = nloc; b.st[1] = nx; }
        const unsigned old = xb_add(&bar[XB_XSUB(b.x)], 1u);
        const unsigned gen = old / nloc;
        if (old + 1u == (gen + 1u) * nloc) {
            __builtin_amdgcn_fence(__ATOMIC_RELEASE, "agent");
            asm volatile("s_waitcnt vmcnt(0)" ::: "memory");
            const unsigned og = xb_add(&bar[XB_TOP], 1u);
            const unsigned tg = og / nx;
            if (og + 1u == (tg + 1u) * nx) xb_add(&bar[XB_TOPGEN], 1u);
            else XB_SPIN(xb_ld(&bar[XB_TOPGEN]) == tg, bar);
            __builtin_amdgcn_fence(__ATOMIC_ACQUIRE, "agent");
            xb_add(&bar[XB_XGEN(b.x)], 1u);
            asm volatile("s_waitcnt vmcnt(0)" ::: "memory");
        } else {
            XB_SPIN(xb_ld(&bar[XB_XGEN(b.x)]) == gen, bar);
            __builtin_amdgcn_fence(__ATOMIC_ACQUIRE, "agent");
            asm volatile("s_waitcnt vmcnt(0)" ::: "memory");
        }
    }
    __syncthreads();
}

#define CTL_EXIT CTL_WORDS
__device__ unsigned g_ctl[CTL_WORDS + 64];
struct Args { const void* in[16]; float* out; unsigned char* ws; };

__global__ void __launch_bounds__(NWAVES * 64, 2) mega_fwd(Args args) {
    extern __shared__ __attribute__((aligned(16))) unsigned char lds[];
    cg::grid_group grid = cg::this_grid();
    const int G = gridDim.x, bx = blockIdx.x;
    const int vcu = (G % 8 == 0) ? (bx % 8) * (G / 8) + bx / 8 : bx;
    const int NGW = G * NWAVES;
    if (threadIdx.x < 64) ((LAS unsigned*)((LAS unsigned char*)lds + MISC_OFF))[threadIdx.x] = 0u;
    __syncthreads();
    if (gridDim.x == 0x7fffffffu) grid.sync();
    const XcdBarrier xbar = xcd_barrier_post(g_ctl, (volatile LAS unsigned*)((LAS unsigned char*)lds + MISC_OFF) + 8);
#define PHASE_IDS() const int tid = opaque_tid(), lane = tid & 63, wave = __builtin_amdgcn_readfirstlane(tid >> 6), gw = vcu * NWAVES + wave; (void)gw; (void)lane
    unsigned char* ws = args.ws;
    const float* x = (const float*)args.in[0]; const int* pos = (const int*)args.in[1];
    const float* g_attn = (const float*)args.in[2]; const float* w_in = (const float*)args.in[3];
    const float* lq1 = (const float*)args.in[4]; const float* lk1 = (const float*)args.in[5]; const float* lq2 = (const float*)args.in[6]; const float* lk2 = (const float*)args.in[7];
    const float* g_diff = (const float*)args.in[8]; const float* g_sb = (const float*)args.in[9];
    const float* w_out = (const float*)args.in[10]; const float* g_ffn = (const float*)args.in[11];
    const float* w_gate = (const float*)args.in[12]; const float* w_up = (const float*)args.in[13]; const float* w_down = (const float*)args.in[14];
    const float* g_fin = (const float*)args.in[15];
    float* out = args.out;
    float* ssq1 = (float*)(ws + WS_SSQ1); float* ssq2 = (float*)(ws + WS_SSQ2); float* rs0 = (float*)(ws + WS_RS0); float* rope = (float*)(ws + WS_ROPE);
    bf16* Win_t = (bf16*)(ws + WS_WIN); bf16* Wout_t = (bf16*)(ws + WS_WOUT); bf16* Wgu_t = (bf16*)(ws + WS_WGU); bf16* Wd_t = (bf16*)(ws + WS_WD);
    bf16* XB = (bf16*)(ws + WS_XB); bf16* OB = XB; bf16* PROJ = (bf16*)(ws + WS_PROJ); bf16* ACT = PROJ; bf16* MIX = (bf16*)(ws + WS_MIX); bf16* X1B = (bf16*)(ws + WS_X1B); bf16* X2B = MIX;

    {
        PHASE_IDS();
        LAS float* scr = (LAS float*)((LAS unsigned char*)lds + wave * 16384);
        constexpr int I_IN = (DMODEL / 64) * (INCOLS / 32), I_OUT = (DMODEL / 64) * (DMODEL / 32), I_G = (DMODEL / 64) * (DFF / 32), I_D = (DFF / 64) * (DMODEL / 32);
        constexpr int NITEMS = I_IN + I_OUT + 2 * I_G + I_D;
        for (int it = gw; it < NITEMS; it += NGW) {
            int r = it;
            if (r < I_IN) { p0_transpose_item(w_in, g_attn, DMODEL, INCOLS, Win_t, 3, scr, r, lane); continue; } r -= I_IN;
            if (r < I_OUT) { p0_transpose_item(w_out, nullptr, DMODEL, DMODEL, Wout_t, 0, scr, r, lane); continue; } r -= I_OUT;
            if (r < I_G) { p0_transpose_item(w_gate, g_ffn, DMODEL, DFF, Wgu_t, 1, scr, r, lane); continue; } r -= I_G;
            if (r < I_G) { p0_transpose_item(w_up, g_ffn, DMODEL, DFF, Wgu_t, 2, scr, r, lane); continue; } r -= I_G;
            p0_transpose_item(w_down, nullptr, DFF, DMODEL, Wd_t, 0, scr, r, lane);
        }
        if (bx == 1 || G == 1) for (int i = tid; i < M / 256; i += NWAVES * 64) ((unsigned*)(ws + WS_CNT))[64 * i] = 0u;
        for (int m4 = gw; m4 < M / 4; m4 += NGW) {
            const int m = 4 * m4;
            const f32x4* xr = (const f32x4*)(x + (size_t)m * DMODEL) + lane;
            f32x4 v[16]; float sr[4];
#pragma unroll
            for (int j = 0; j < 16; ++j) v[j] = __builtin_nontemporal_load(&xr[64 * j]);
#pragma unroll
            for (int r = 0; r < 4; ++r) { float t = 0.f;
#pragma unroll
                for (int j = 0; j < 4; ++j) { const f32x4 q = v[4 * r + j]; t += (q.x * q.x + q.y * q.y) + (q.z * q.z + q.w * q.w); }
                sr[r] = wave_sum(t); }
            if (lane < 4) { const float t = lane == 0 ? sr[0] : lane == 1 ? sr[1] : lane == 2 ? sr[2] : sr[3]; rs0[m + lane] = 1.0f / sqrtf(t * (1.0f / DMODEL) + EPS); }
            unsigned long long* o8 = (unsigned long long*)(XB + (size_t)m * DMODEL) + lane;
#pragma unroll
            for (int j = 0; j < 16; ++j) o8[64 * j] = (unsigned long long)pk2(v[j].x, v[j].y) | ((unsigned long long)pk2(v[j].z, v[j].w) << 32);
        }
        for (int m8 = gw; m8 < M / 8; m8 += NGW) {
            const int m = 8 * m8 + (lane >> 3), fi = lane & 7;
            const float invf = fi == 0 ? 1.0f : fi == 1 ? 0.19392274474868576f : fi == 2 ? 0.03760603093086393f : fi == 3 ? 0.007292664737217109f
                             : fi == 4 ? 0.001414213562373095f : fi == 5 ? 0.0002742481756762073f : fi == 6 ? 5.318295896944988e-05f : 1.031338537721246e-05f;
            const float angf = (float)pos[m] * invf; const double a = (double)angf;
            const double kq = __builtin_rint(a * 0.63661977236758134308); const double r = a - kq * 1.57079632679489661923; const int q = ((int)kq) & 3;
            const double r2 = r * r;
            const double sn = r * (1.0 + r2 * (-1.0 / 6 + r2 * (1.0 / 120 + r2 * (-1.0 / 5040 + r2 * (1.0 / 362880 + r2 * (-1.0 / 39916800 + r2 * (1.0 / 6227020800.0)))))));
            const double cs = 1.0 + r2 * (-0.5 + r2 * (1.0 / 24 + r2 * (-1.0 / 720 + r2 * (1.0 / 40320 + r2 * (-1.0 / 3628800 + r2 * (1.0 / 479001600.0 + r2 * (-1.0 / 87178291200.0)))))));
            const double c_ = (q == 0) ? cs : (q == 1) ? -sn : (q == 2) ? -cs : sn;
            const double s_ = (q == 0) ? sn : (q == 1) ? cs : (q == 2) ? -sn : -cs;
            rope[(size_t)m * 16 + fi] = (float)c_; rope[(size_t)m * 16 + 8 + fi] = (float)s_;
        }
    }
    xcd_barrier(xbar);

    {
        pg8::Gemm g{XB, Win_t, M, INCOLS, DMODEL}; pg8::StaticOrder S; S.init(M, INCOLS, G, bx);
        pg8::EpiInProj E{PROJ, rs0, rope, (bf16*)(ws + WS_KT), (bf16*)(ws + WS_VT)};
        pg8::gemm_phase<pg8::EpiInProj, pg8::StaticOrder, true, true>((LAS unsigned char*)lds, g, S, E);
    }
    xcd_barrier(xbar);

    {
        for (int job = vcu; job < BATCH * 4 * 2; job += G) {
            const int bh = job >> 1, half = job & 1, b = bh >> 2, h = bh & 3;
            attn_body::bf16x8 qfrag[4];
            for (int p = 0; p < 4; ++p) {
                const int mp = p >> 1, vh = p & 1;
                const attn_body::bf16* Q = (const attn_body::bf16*)PROJ + (h * 2 + mp) * 64;
                const attn_body::bf16* K = (const attn_body::bf16*)(ws + WS_KT) + ((size_t)(b * 8 + h * 2 + mp) << 17);
                const attn_body::bf16* V = (const attn_body::bf16*)(ws + WS_VT) + ((size_t)(b * 8 + h * 2 + vh) << 17);
                attn_body::bf16* O = (attn_body::bf16*)OB + (h * 4 + p) * 64;
                const int np = p + 1, nmp = np >> 1, nvh = np & 1;
                const long dQn = (long)((nmp - mp) * 64), dKn = (long)(nmp - mp) * 131072L, dVn = (long)(nvh - vh) * 131072L;
#define QB_OF(i_) ((i_) == 0 ? 7 - half : (i_) == 1 ? 4 + half : (i_) == 2 ? 3 - half : half)
                for (int i = 0; i < 4; ++i) { const int qb = QB_OF(i);
                    const bool first = (p == 0 && i == 0), last = (p == 3 && i == 3);
                    const int ni = (i + 1) & 3, nqb = QB_OF(ni);
                    attn_body::attn_unit<8>(b, qb, Q, K, V, O, (char*)lds, !first, !last, (i == 3) ? dKn : 0L, (i == 3) ? dVn : 0L, qfrag, nqb, (i == 3) ? dQn : 0L); }
            }
            asm volatile("s_waitcnt vmcnt(0)" ::: "memory"); __syncthreads();
            __builtin_amdgcn_fence(__ATOMIC_ACQUIRE, "agent");
            {
                PHASE_IDS();
                const float s1 = wave_sum(lq1[lane] * lk1[lane]), s2 = wave_sum(lq2[lane] * lk2[lane]);
                const float lam = expf(s1) - expf(s2) + LAMBDA_INIT;
                const int rr = lane >> 4, j = lane & 15, vh = j >> 3, c8 = (j & 7) * 8;
                const f32x4 ga = *(const f32x4*)(g_diff + j * 8), gb = *(const f32x4*)(g_diff + j * 8 + 4);
                for (int i = 0; i < 4; ++i) {
                    const int qb = QB_OF(i);
                    const size_t row0 = (size_t)b * SEQ + qb * 256 + wave * 32;
#pragma unroll 2
                    for (int it = 0; it < 8; ++it) {
                        const size_t m = row0 + it * 4 + rr;
                        const bf16* orow = OB + m * 1024 + (h * 4 + vh) * 64 + c8;
                        const v4u a = *(const v4u*)orow, c = *(const v4u*)(orow + 128);
                        float d[8];
#pragma unroll
                        for (int k = 0; k < 4; ++k) { const unsigned ua = a[k], uc = c[k];
                            d[2 * k] = __builtin_bit_cast(float, ua << 16) - lam * __builtin_bit_cast(float, uc << 16);
                            d[2 * k + 1] = __builtin_bit_cast(float, ua & 0xffff0000u) - lam * __builtin_bit_cast(float, uc & 0xffff0000u); }
                        float ss = 0.f;
#pragma unroll
                        for (int k = 0; k < 8; ++k) ss += d[k] * d[k];
                        ss += __shfl_xor(ss, 1); ss += __shfl_xor(ss, 2); ss += __shfl_xor(ss, 4); ss += __shfl_xor(ss, 8);
                        const float rstd = (1.0f - LAMBDA_INIT) / sqrtf(ss * (1.0f / 128.0f) + EPS);
                        v4u o; o.x = pk2(d[0] * rstd * ga[0], d[1] * rstd * ga[1]); o.y = pk2(d[2] * rstd * ga[2], d[3] * rstd * ga[3]);
                        o.z = pk2(d[4] * rstd * gb[0], d[5] * rstd * gb[1]); o.w = pk2(d[6] * rstd * gb[2], d[7] * rstd * gb[3]);
                        *(v4u*)(MIX + m * 1024 + h * 128 + j * 8) = o;
                    }
                }
            }
        }
        {
            const int wv = __builtin_amdgcn_readfirstlane(opaque_tid() >> 6);
            unsigned* qh = g_ctl + SBQ_WORD0;
            constexpr unsigned QITEMS = (BATCH * 8 / 8) * 32;
            unsigned myq = xbar.x & 7u, steal = 0u;
            unsigned raw = 0u;
            { const int ln = opaque_tid() & 63; if (ln == 0) raw = __hip_atomic_fetch_add(qh + 64 * myq, 1u, __ATOMIC_RELAXED, __HIP_MEMORY_SCOPE_AGENT); raw = (unsigned)__builtin_amdgcn_readfirstlane(raw); }
            for (;;) {
                while (raw >= QITEMS && steal < 8u) {
                    ++steal; if (steal >= 8u) break;
                    myq = (myq + 1u) & 7u;
                    const int ln = opaque_tid() & 63; unsigned r2 = 0u; if (ln == 0) r2 = __hip_atomic_fetch_add(qh + 64 * myq, 1u, __ATOMIC_RELAXED, __HIP_MEMORY_SCOPE_AGENT); raw = (unsigned)__builtin_amdgcn_readfirstlane(r2);
                }
                if (raw >= QITEMS) break;
                const unsigned it = raw, q = myq;
                { const int ln = opaque_tid() & 63; unsigned r2 = 0u; if (ln == 0) r2 = __hip_atomic_fetch_add(qh + 64 * myq, 1u, __ATOMIC_RELAXED, __HIP_MEMORY_SCOPE_AGENT); raw = (unsigned)__builtin_amdgcn_readfirstlane(r2); }
                const int job = (int)(q + 8u * (it >> 5)), gq = (int)(it & 31u), b = job >> 3, h = job & 7;
                const attn_body::bf16* Q = (const attn_body::bf16*)PROJ + 1536 + h * 64;
                const attn_body::bf16* K = (const attn_body::bf16*)PROJ + 2048 + h * 64;
                const attn_body::bf16* V = (const attn_body::bf16*)PROJ + 2560 + h * 64;
                attn_body::bf16* O = (attn_body::bf16*)MIX + 512 + h * 64;
                attn_body::sb_item(b, gq, Q, K, V, O, g_sb, (char*)lds + wv * 16384);
            }
        }
    }
    xcd_barrier(xbar);

    {
        pg8::Gemm g{MIX, Wout_t, M, DMODEL, DMODEL}; pg8::StaticOrder S; S.init(M, DMODEL, G, bx);
        pg8::EpiResid<false> E{x, X1B, ssq1};
        pg8::gemm_phase<pg8::EpiResid<false>, pg8::StaticOrder, true, true>((LAS unsigned char*)lds, g, S, E);
    }
    xcd_barrier(xbar);

    {
        pg8::Gemm g{X1B, Wgu_t, M, 2 * DFF, DMODEL}; pg8::StaticOrder S; S.init(M, 2 * DFF, G, bx);
        pg8::EpiSwiGLU E{ACT, ssq1, DFF};
        pg8::gemm_phase<pg8::EpiSwiGLU, pg8::StaticOrder, true, true>((LAS unsigned char*)lds, g, S, E);
    }
    xcd_barrier(xbar);

    {
        pg8::Gemm g{ACT, Wd_t, M, DMODEL, DFF}; pg8::StaticOrder S; S.init(M, DMODEL, G, bx);
        pg8::EpiFinal E{X1B, out, g_fin, (float*)(ws + WS_XBUF), (unsigned*)(ws + WS_CNT), (LAS unsigned char*)lds + RING_BYTES + 1024};
        pg8::gemm_phase<pg8::EpiFinal, pg8::StaticOrder, true, true>((LAS unsigned char*)lds, g, S, E);
    }
    {
        __syncthreads();
        LAS unsigned* lastf = (LAS unsigned*)((LAS unsigned char*)lds + MISC_OFF) + 16;
        if (threadIdx.x == 0) { const unsigned old = __hip_atomic_fetch_add(g_ctl + CTL_EXIT, 1u, __ATOMIC_ACQ_REL, __HIP_MEMORY_SCOPE_AGENT); *lastf = (old == (unsigned)G - 1u) ? 1u : 0u; }
        __syncthreads();
        if (*lastf) {
            for (int i = threadIdx.x; i < CTL_WORDS + 64; i += NWAVES * 64) __hip_atomic_store(g_ctl + i, 0u, __ATOMIC_RELAXED, __HIP_MEMORY_SCOPE_AGENT);
        }
    }
}

extern "C" void kernel_launch(void* const* d_in, const int* in_sizes, int n_in, void* d_out, int out_size, void* d_ws, size_t ws_size, hipStream_t stream) {
    static int grid = 0;
    if (grid == 0) {
        if (n_in != 16 || in_sizes[0] != M * DMODEL || out_size != M * DMODEL || ws_size < WS_END) { fprintf(stderr, "kernel_launch: unexpected shapes (n_in %d, in0 %d, out %d, ws %zu); nothing launched\n", n_in, n_in > 0 ? in_sizes[0] : -1, out_size, ws_size); grid = -1; return; }
        int dev = 0, cus = 0, per_cu = 0;
        if (hipGetDevice(&dev) != hipSuccess || hipDeviceGetAttribute(&cus, hipDeviceAttributeMultiprocessorCount, dev) != hipSuccess) { grid = -1; return; }
        if (hipFuncSetAttribute((const void*)mega_fwd, hipFuncAttributeMaxDynamicSharedMemorySize, LDS_BYTES) != hipSuccess) { fprintf(stderr, "kernel_launch: hipFuncSetAttribute failed\n"); grid = -1; return; }
        if (hipOccupancyMaxActiveBlocksPerMultiprocessor(&per_cu, (const void*)mega_fwd, NWAVES * 64, LDS_BYTES) != hipSuccess || per_cu < 1) { fprintf(stderr, "kernel_launch: occupancy query reports %d\n", per_cu); per_cu = 1; }
        (void)hipGetLastError();
        grid = cus * per_cu;
    }
    if (grid < 0) return;
    Args a{};
    for (int i = 0; i < 16; ++i) a.in[i] = d_in[i];
    a.out = (float*)d_out; a.ws = (unsigned char*)d_ws;
    void* kargs[] = {&a};
    const hipError_t le = hipLaunchCooperativeKernel((const void*)mega_fwd, dim3(grid), dim3(NWAVES * 64), kargs, LDS_BYTES, stream);
    if (le != hipSuccess) fprintf(stderr, "kernel_launch: cooperative launch failed: %s (grid %d)\n", hipGetErrorName(le), grid);
}
```
